# Optimizing an MI355X kernel written in HIP

```python
import jax, jax.numpy as jnp
from jax import lax
import numpy as np

D_MODEL = 1024
BATCH = 4
SEQ = 8192
DEPTH = 1

FOURIER_GROUPS = 4
FOURIER_WIDTH = D_MODEL // 2
FOURIER_GROUP_DIM = FOURIER_WIDTH // FOURIER_GROUPS
MLA_HEADS = 8
QK_NOPE_DIM = 64
QK_ROPE_DIM = 32
V_HEAD_DIM = (D_MODEL // 2) // MLA_HEADS
Q_LORA_RANK = 384
KV_LORA_RANK = 256
Q_BLOCK = 128
ROPE_THETA = 10000.0
D_FF = 2816
NORM_EPS = 1e-6
N_ADA = 9
W_IN_COLS = FOURIER_WIDTH + Q_LORA_RANK + KV_LORA_RANK + QK_ROPE_DIM + 2 * D_MODEL
SPLIT_1 = FOURIER_WIDTH
SPLIT_2 = SPLIT_1 + Q_LORA_RANK
SPLIT_3 = SPLIT_2 + KV_LORA_RANK
SPLIT_4 = SPLIT_3 + QK_ROPE_DIM

kernel_name = "hybrid_fourier_mla_macaron_adaln_encoder"


def rms_norm(x, g):
    x32 = x.astype(jnp.float32)
    y = x32 * lax.rsqrt(jnp.mean(x32 * x32, axis=-1, keepdims=True) + NORM_EPS)
    return (y * g.astype(jnp.float32)).astype(x.dtype)


def modulate(h, shift, scale):
    return h * (1 + scale[:, None, :]) + shift[:, None, :]


def swiglu(h, w_gate, w_up, w_down):
    return (jax.nn.silu(h @ w_gate) * (h @ w_up)) @ w_down


def rope_tables(positions):
    half = QK_ROPE_DIM // 2
    inv_freq = 1.0 / (ROPE_THETA ** (jnp.arange(half, dtype=jnp.float32) * 2.0 / QK_ROPE_DIM))
    ang = positions.astype(jnp.float32)[..., None] * inv_freq
    return jnp.cos(ang), jnp.sin(ang)


def apply_rope(x, cos, sin):
    x32 = x.astype(jnp.float32)
    x1, x2 = jnp.split(x32, 2, axis=-1)
    out = jnp.concatenate([x1 * cos - x2 * sin, x2 * cos + x1 * sin], axis=-1)
    return out.astype(x.dtype)


def fourier_mix(u):
    b, s, _ = u.shape
    ug = u.reshape(b, s, FOURIER_GROUPS, FOURIER_GROUP_DIM).astype(jnp.float32)
    f = jnp.fft.fft2(ug, axes=(1, 3), norm="ortho").real
    return f.reshape(b, s, FOURIER_WIDTH).astype(u.dtype)


def mla_attention(q_lat, kv_lat, k_rope, positions, q_norm, w_q_up, kv_norm, w_kv_up):
    b, s, _ = q_lat.shape
    q = (rms_norm(q_lat, q_norm) @ w_q_up).reshape(b, s, MLA_HEADS, QK_NOPE_DIM + QK_ROPE_DIM)
    kv = (rms_norm(kv_lat, kv_norm) @ w_kv_up).reshape(b, s, MLA_HEADS, QK_NOPE_DIM + V_HEAD_DIM)
    q_nope, q_rot = q[..., :QK_NOPE_DIM], q[..., QK_NOPE_DIM:]
    k_nope, v = kv[..., :QK_NOPE_DIM], kv[..., QK_NOPE_DIM:]
    cos, sin = rope_tables(positions)
    q_rot = apply_rope(q_rot, cos[:, :, None, :], sin[:, :, None, :])
    k_rot = apply_rope(k_rope, cos, sin)
    sm_scale = (QK_NOPE_DIM + QK_ROPE_DIM) ** -0.5
    q_nope = q_nope * sm_scale
    q_rot = q_rot * sm_scale
    n_blk = s // Q_BLOCK
    qn_b = q_nope.reshape(b, n_blk, Q_BLOCK, MLA_HEADS, QK_NOPE_DIM).transpose(1, 0, 2, 3, 4)
    qr_b = q_rot.reshape(b, n_blk, Q_BLOCK, MLA_HEADS, QK_ROPE_DIM).transpose(1, 0, 2, 3, 4)

    def attend(blk):
        qn_i, qr_i = blk
        scores = (jnp.einsum('bqhd,bkhd->bhqk', qn_i, k_nope)
                  + jnp.einsum('bqhr,bkr->bhqk', qr_i, k_rot))
        p = jax.nn.softmax(scores.astype(jnp.float32), axis=-1).astype(v.dtype)
        return jnp.einsum('bhqk,bkhd->bqhd', p, v)

    o = lax.map(attend, (qn_b, qr_b))
    return o.transpose(1, 0, 2, 3, 4).reshape(b, s, MLA_HEADS * V_HEAD_DIM)


def setup_inputs(seed: int = 0) -> dict:
    key = jax.random.key(seed)
    ks = jax.random.split(key, 24)
    f32 = jnp.float32

    def w(k, shape, fan_in, gain=1.0):
        return (jax.random.normal(k, shape, f32) * (gain * fan_in ** -0.5)).astype(f32)

    def gain(k, shape):
        return 1.0 + 0.02 * jax.random.normal(k, shape, f32)

    L, D = DEPTH, D_MODEL
    x = jax.random.normal(ks[0], (BATCH, SEQ, D), f32)
    c = jax.random.normal(ks[1], (BATCH, D), f32)
    offs = jax.random.randint(ks[2], (BATCH, 1), 0, 1024, dtype=jnp.int32)
    positions = (offs + jnp.arange(SEQ, dtype=jnp.int32)[None, :]).astype(jnp.int32)
    return {
        "x": x,
        "c": c,
        "positions": positions,
        "ada_w": w(ks[3], (L, D, N_ADA * D), D, 0.2),
        "ada_b": 0.02 * jax.random.normal(ks[4], (L, N_ADA * D), f32),
        "ffn1_norm": gain(ks[5], (L, D)),
        "ffn1_w_gate": w(ks[6], (L, D, D_FF), D),
        "ffn1_w_up": w(ks[7], (L, D, D_FF), D),
        "ffn1_w_down": w(ks[8], (L, D_FF, D), D_FF),
        "mix_norm": gain(ks[9], (L, D)),
        "w_in": w(ks[10], (L, D, W_IN_COLS), D),
        "q_norm": gain(ks[11], (L, Q_LORA_RANK)),
        "w_q_up": w(ks[12], (L, Q_LORA_RANK, MLA_HEADS * (QK_NOPE_DIM + QK_ROPE_DIM)), Q_LORA_RANK),
        "kv_norm": gain(ks[13], (L, KV_LORA_RANK)),
        "w_kv_up": w(ks[14], (L, KV_LORA_RANK, MLA_HEADS * (QK_NOPE_DIM + V_HEAD_DIM)), KV_LORA_RANK),
        "w_fourier_out": w(ks[15], (L, FOURIER_WIDTH, D), FOURIER_WIDTH),
        "w_mla_out": w(ks[16], (L, MLA_HEADS * V_HEAD_DIM, D), MLA_HEADS * V_HEAD_DIM),
        "w_out": w(ks[17], (L, D, D), D),
        "ffn2_norm": gain(ks[18], (L, D)),
        "ffn2_w_gate": w(ks[19], (L, D, D_FF), D),
        "ffn2_w_up": w(ks[20], (L, D, D_FF), D),
        "ffn2_w_down": w(ks[21], (L, D_FF, D), D_FF),
        "final_norm": gain(ks[22], (D,)),
    }


def reference(x, c, positions, ada_w, ada_b, ffn1_norm, ffn1_w_gate, ffn1_w_up, ffn1_w_down,
              mix_norm, w_in, q_norm, w_q_up, kv_norm, w_kv_up, w_fourier_out, w_mla_out, w_out,
              ffn2_norm, ffn2_w_gate, ffn2_w_up, ffn2_w_down, final_norm):
    c_act = jax.nn.silu(c)
    for l in range(DEPTH):
        mod = c_act @ ada_w[l] + ada_b[l]
        (sh1, sc1, g1, sh2, sc2, g2, sh3, sc3, g3) = jnp.split(mod, N_ADA, axis=-1)

        h = modulate(rms_norm(x, ffn1_norm[l]), sh1, sc1)
        x = x + 0.5 * g1[:, None, :] * swiglu(h, ffn1_w_gate[l], ffn1_w_up[l], ffn1_w_down[l])

        h = modulate(rms_norm(x, mix_norm[l]), sh2, sc2)
        z = h @ w_in[l]
        u_f, q_lat, kv_lat, k_rope, gate_logits = jnp.split(
            z, [SPLIT_1, SPLIT_2, SPLIT_3, SPLIT_4], axis=-1)
        y_a = fourier_mix(u_f) @ w_fourier_out[l]
        y_b = mla_attention(q_lat, kv_lat, k_rope, positions, q_norm[l], w_q_up[l],
                            kv_norm[l], w_kv_up[l]) @ w_mla_out[l]
        gate_a, gate_b = jnp.split(jax.nn.sigmoid(gate_logits), 2, axis=-1)
        y = (gate_a * y_a + gate_b * y_b) @ w_out[l]
        x = x + g2[:, None, :] * y

        h = modulate(rms_norm(x, ffn2_norm[l]), sh3, sc3)
        x = x + 0.5 * g3[:, None, :] * swiglu(h, ffn2_w_gate[l], ffn2_w_up[l], ffn2_w_down[l])
    return rms_norm(x, final_norm)
```

```cpp
#include <hip/hip_runtime.h>
#include <cstdio>
#include <cstdint>

#define LAS __attribute__((address_space(3)))
#define GAS __attribute__((address_space(1)))
typedef unsigned short bf16_t;
typedef short bf16x8 __attribute__((ext_vector_type(8)));
typedef short s16x4 __attribute__((ext_vector_type(4)));
typedef float f32x4 __attribute__((ext_vector_type(4)));
typedef float f32x2 __attribute__((ext_vector_type(2)));
typedef float f32x16 __attribute__((ext_vector_type(16)));
typedef unsigned u32x4 __attribute__((ext_vector_type(4)));
typedef unsigned u32x2 __attribute__((ext_vector_type(2)));

#ifndef MK_SINGLE
#define MK_SINGLE 0
#endif

constexpr int BATCH = 4, SEQ = 8192, DM = 1024, MTOK = BATCH * SEQ, DFF = 2816, NADA = 9 * DM;
constexpr int NWIN = 3840;
constexpr int QLR = 384, KVLR = 256, NQ = 768, NKV = 1024, ZLW = 768;
constexpr float NORM_EPS = 1e-6f;
constexpr float SCQ = 0.10206207261596575f * 1.4426950408889634f;

constexpr size_t MiB = 1u << 20;
constexpr size_t WS_CTL = 0, CTL_ZERO_BYTES = 2 * MiB;
constexpr size_t OFF_MOD = 256 * 1024, OFF_RSQQ = 512 * 1024, OFF_RSQKV = 640 * 1024;
constexpr size_t WS_ROPE = 2 * MiB;
constexpr size_t WS_TW = 6 * MiB;
constexpr size_t WS_C64 = 6 * MiB + 64 * 1024, WS_S64 = WS_C64 + 8192, WS_NS64 = WS_S64 + 8192;
constexpr size_t WS_C128 = 6 * MiB + 128 * 1024, WS_S128 = WS_C128 + 32768;
constexpr size_t WS_WGU1 = 8 * MiB, WS_WD1 = 19 * MiB, WS_WGU2 = 25 * MiB, WS_WD2 = 36 * MiB, WS_WIN = 42 * MiB;
constexpr size_t WS_WQ = 50 * MiB, WS_WKV = 51 * MiB, WS_WF = 52 * MiB, WS_WM = 53 * MiB, WS_WO = 54 * MiB;
constexpr size_t WS_H = 64 * MiB;
constexpr size_t WS_KV = 128 * MiB;
constexpr size_t WS_GATES = 192 * MiB;
constexpr size_t WS_KR = 320 * MiB;
constexpr size_t WS_BIG = 322 * MiB;
constexpr size_t WS_V = WS_BIG, WS_F = WS_BIG, WS_Y = WS_BIG + 64 * MiB, WS_ZL = WS_BIG + 128 * MiB, WS_O = WS_ZL;
constexpr size_t WS_END = 498 * MiB;
constexpr int CW_BAR = 4096;

typedef __bf16 bf16x2_t __attribute__((ext_vector_type(2)));
__device__ __forceinline__ unsigned cvt_pk_bf16(float lo, float hi) { f32x2 v = {lo, hi}; bf16x2_t b = __builtin_convertvector(v, bf16x2_t); return __builtin_bit_cast(unsigned, b); }
__device__ __forceinline__ float bf_lo(unsigned w) { return __uint_as_float(w << 16); }
__device__ __forceinline__ float bf_hi(unsigned w) { return __uint_as_float(w & 0xffff0000u); }
__device__ __forceinline__ u32x4 pack8(f32x4 a, f32x4 b) { u32x4 w; w.x = cvt_pk_bf16(a[0], a[1]); w.y = cvt_pk_bf16(a[2], a[3]); w.z = cvt_pk_bf16(b[0], b[1]); w.w = cvt_pk_bf16(b[2], b[3]); return w; }
__device__ __forceinline__ float fast_sigmoid(float v) { return __builtin_amdgcn_rcpf(1.0f + __builtin_amdgcn_exp2f(-1.4426950408889634f * v)); }
__device__ __forceinline__ float wave_sum(float v) {
#pragma unroll
  for (int o = 1; o < 64; o <<= 1) v += __shfl_xor(v, o);
  return v;
}
__device__ __forceinline__ int fresh_lane() { int l; asm volatile("v_mbcnt_lo_u32_b32 %0, -1, 0\n\tv_mbcnt_hi_u32_b32 %0, -1, %0" : "=v"(l)); return l; }
#define LDS_WAIT() asm volatile("s_waitcnt lgkmcnt(0)" ::: "memory")
#define VM_WAIT() asm volatile("s_waitcnt vmcnt(0)" ::: "memory")

namespace pg8 {
constexpr int BM = 256, BK = 64, HALF = 128, HTB = HALF * BK * 2, STAGE_BYTES = 8 * HTB, NXCD = 8, WGM = 8;
__host__ __device__ __forceinline__ int lds_byte(int r, int c) { const int st = (r >> 4) * 2 + (c >> 5), rr = r & 15, cc = c & 31, ob = rr * 64 + cc * 2; return st * 1024 + (ob ^ (((ob >> 9) & 1) << 5)); }
__host__ __device__ __forceinline__ void stage_rc(int b, int& R, int& C) { const int st = b / 1024, sb = b % 1024, swz = sb ^ (((sb >> 9) & 1) << 5); R = (st >> 1) * 16 + swz / 64; C = (st & 1) * 32 + (swz % 64) / 2; }
__host__ __device__ __forceinline__ int perm32(int rho) { const int n = rho >> 4, i = rho & 15; return 8 * (i >> 2) + 4 * n + (i & 3); }
struct Unit { int pm, pn; };
struct Gemm { const bf16_t* A; const bf16_t* Bt; int M, N, K, lda, ldb; };
struct StaticOrder {
  int nM, nN, nwg, G, c;
  __host__ __device__ void init(int M, int N, int G_, int c_) { nM = M / BM; nN = N / BM; nwg = nM * nN; G = G_; c = c_; }
  __host__ __device__ bool next(int i, Unit& u) const {
    const long L = (long)i * G + c; if (L >= nwg) return false;
    int wgid = (int)L; { const int q = nwg / NXCD, r = nwg % NXCD, xcd = wgid % NXCD, off = wgid / NXCD; wgid = (xcd < r ? xcd * (q + 1) : r * (q + 1) + (xcd - r) * q) + off; }
    const int nig = WGM * nN, gid = wgid / nig, fm = gid * WGM, gsz = (nM - fm) < WGM ? (nM - fm) : WGM;
    u.pm = fm + ((wgid % nig) % gsz); u.pn = (wgid % nig) / gsz; return true;
  }
};
template <class Epi, class Sched, bool ALIGN_EPI = true, bool SP2 = true>
__device__ __forceinline__ void gemm_phase(LAS unsigned char* lds, const Gemm g, const Sched& S, const Epi& E, const int wid) {
  const int lane0 = fresh_lane();
  const int tid = wid * 64 + lane0, wr = wid >> 2, wc = wid & 3, fr = lane0 & 15, fq = lane0 >> 4;
  const int K = g.K, nt = K / BK;
  unsigned voffA[2], voffB[2];
#pragma unroll
  for (int i = 0; i < 2; ++i) { int R, C; stage_rc(tid * 16 + i * 8192, R, C); const int Rb = Epi::PERM ? ((R & ~31) + perm32(R & 31)) : R;
    voffA[i] = (unsigned)(R * g.lda + C) * 2u; voffB[i] = (unsigned)(Rb * g.ldb + C) * 2u; }
  const size_t kstep = (size_t)(BK * 2);
  const size_t hstepA = (size_t)HALF * g.lda * 2, hstepB = (size_t)HALF * g.ldb * 2;
  const size_t tstepA = 2 * hstepA, tstepB = 2 * hstepB;
  const unsigned ldsw = (unsigned)wid * 1024u;
  const int aoff = lds_byte(wr * 64 + fr, fq * 8), boff = lds_byte(wc * 32 + fr, fq * 8);
#define PG8_SA(b, h) (((b) * 2 + (h)) * HTB)
#define PG8_SB(b, h) ((4 + (b) * 2 + (h)) * HTB)
#define PG8_STAGE(bufoff, gbase, voff) do { _Pragma("unroll") for (int _i = 0; _i < 2; ++_i) \
    __builtin_amdgcn_global_load_lds((const unsigned*)((const char*)(gbase) + (voff)[_i]), (LAS unsigned*)(lds + (bufoff) + ldsw + _i * 8192), 16, 0, 0); } while (0)
#define PG8_LDA(dst, b, h) do { _Pragma("unroll") for (int m = 0; m < 4; ++m) _Pragma("unroll") for (int k = 0; k < 2; ++k) dst[m][k] = *(const LAS bf16x8*)(lds + PG8_SA(b, h) + aoff + m * 2048 + k * 1024); } while (0)
#define PG8_LDB(dst, b, h) do { _Pragma("unroll") for (int n = 0; n < 2; ++n) _Pragma("unroll") for (int k = 0; k < 2; ++k) dst[n][k] = *(const LAS bf16x8*)(lds + PG8_SB(b, h) + boff + n * 2048 + k * 1024); } while (0)
#define PG8_MMA(ai, bj, At, Bt) do { __builtin_amdgcn_s_setprio(1); _Pragma("unroll") for (int m = 0; m < 4; ++m) _Pragma("unroll") for (int n = 0; n < 2; ++n) _Pragma("unroll") for (int k = 0; k < 2; ++k) \
    acc[ai][bj][m][n] = __builtin_amdgcn_mfma_f32_16x16x32_bf16(Bt[n][k], At[m][k], acc[ai][bj][m][n], 0, 0, 0); __builtin_amdgcn_s_setprio(0); } while (0)
#define PG8_WAIT_V(n) asm volatile("s_waitcnt vmcnt(" #n ")" ::: "memory")
#define PG8_WAIT_L(n) asm volatile("s_waitcnt lgkmcnt(" #n ")" ::: "memory")
#define PG8_BAR __builtin_amdgcn_s_barrier()
#define PG8_SCHED __builtin_amdgcn_sched_barrier(0)
  Unit cur, nxt; int ui = 0;
  if (!S.next(0, cur)) return;
  f32x4 acc[2][2][4][2];
#pragma unroll
  for (int a = 0; a < 2; ++a)
#pragma unroll
    for (int b = 0; b < 2; ++b)
#pragma unroll
      for (int m = 0; m < 4; ++m)
#pragma unroll
        for (int n = 0; n < 2; ++n) acc[a][b][m][n] = (f32x4){0.f, 0.f, 0.f, 0.f};
  bf16x8 At[4][2], B0[2][2], B1[2][2];
  const char* cA = (const char*)g.A + (size_t)cur.pm * tstepA; const char* cB = (const char*)g.Bt + (size_t)cur.pn * tstepB;
  if constexpr (SP2) {
    PG8_STAGE(PG8_SB(0, 0), cB, voffB); PG8_STAGE(PG8_SB(0, 1), cB + hstepB, voffB); PG8_STAGE(PG8_SA(0, 0), cA, voffA); PG8_STAGE(PG8_SA(0, 1), cA + hstepA, voffA);
    if (wr == 1) PG8_BAR;
    PG8_WAIT_V(2); PG8_BAR;
    PG8_STAGE(PG8_SB(1, 0), cB + kstep, voffB); PG8_STAGE(PG8_SA(1, 0), cA + kstep, voffA); PG8_STAGE(PG8_SB(1, 1), cB + hstepB + kstep, voffB);
    PG8_WAIT_V(6); PG8_BAR;
  } else {
    PG8_STAGE(PG8_SB(0, 0), cB, voffB); PG8_STAGE(PG8_SA(0, 0), cA, voffA); PG8_STAGE(PG8_SB(0, 1), cB + hstepB, voffB); PG8_STAGE(PG8_SA(0, 1), cA + hstepA, voffA);
    if (wr == 1) PG8_BAR;
    PG8_WAIT_V(4); PG8_BAR;
    PG8_STAGE(PG8_SB(1, 0), cB + kstep, voffB); PG8_STAGE(PG8_SA(1, 0), cA + kstep, voffA); PG8_STAGE(PG8_SB(1, 1), cB + hstepB + kstep, voffB);
    PG8_WAIT_V(6); PG8_BAR;
  }
  for (;;) {
    const bool has_next = S.next(ui + 1, nxt);
    const char* nA = has_next ? (const char*)g.A + (size_t)nxt.pm * tstepA : cA; const char* nB = has_next ? (const char*)g.Bt + (size_t)nxt.pn * tstepB : cB;
    for (int t = 0; t < nt; t += 2) {
      const bool last = (t == nt - 2);
      const char* a1 = cA + (size_t)(t + 1) * kstep;
      const char* a2 = last ? nA : cA + (size_t)(t + 2) * kstep; const char* b2 = last ? nB : cB + (size_t)(t + 2) * kstep;
      const char* a3 = a2 + kstep; const char* b3 = b2 + kstep;
      if constexpr (SP2) {
        PG8_LDB(B0, 0, 0); PG8_LDB(B1, 0, 1); PG8_SCHED; PG8_LDA(At, 0, 0); PG8_STAGE(PG8_SA(1, 1), a1 + hstepA, voffA);
        PG8_WAIT_V(8); PG8_WAIT_L(0); PG8_BAR; PG8_MMA(0, 0, At, B0); PG8_MMA(0, 1, At, B1); PG8_BAR; PG8_SCHED;
        PG8_LDA(At, 0, 1); PG8_STAGE(PG8_SB(0, 0), b2, voffB); PG8_STAGE(PG8_SB(0, 1), b2 + hstepB, voffB); PG8_STAGE(PG8_SA(0, 0), a2, voffA);
        PG8_WAIT_V(8); PG8_WAIT_L(0); PG8_BAR; PG8_MMA(1, 0, At, B0); PG8_MMA(1, 1, At, B1); PG8_BAR; PG8_SCHED;
        PG8_LDB(B0, 1, 0); PG8_LDB(B1, 1, 1); PG8_SCHED; PG8_LDA(At, 1, 0); PG8_STAGE(PG8_SA(0, 1), a2 + hstepA, voffA);
        PG8_WAIT_V(8); PG8_WAIT_L(0); PG8_BAR; PG8_MMA(0, 0, At, B0); PG8_MMA(0, 1, At, B1); PG8_BAR; PG8_SCHED;
        PG8_LDA(At, 1, 1); PG8_STAGE(PG8_SB(1, 0), b3, voffB); PG8_STAGE(PG8_SB(1, 1), b3 + hstepB, voffB); PG8_STAGE(PG8_SA(1, 0), a3, voffA);
        PG8_WAIT_V(8); PG8_WAIT_L(0); PG8_BAR; PG8_MMA(1, 0, At, B0); PG8_MMA(1, 1, At, B1); PG8_BAR; PG8_SCHED;
      } else {
        PG8_LDB(B0, 0, 0); PG8_SCHED; PG8_LDA(At, 0, 0); PG8_STAGE(PG8_SA(1, 1), a1 + hstepA, voffA);
        PG8_WAIT_L(8); PG8_BAR; PG8_WAIT_L(0); PG8_MMA(0, 0, At, B0); PG8_BAR; PG8_SCHED;
        PG8_LDB(B1, 0, 1); PG8_STAGE(PG8_SB(0, 0), b2, voffB);
        PG8_BAR; PG8_WAIT_L(0); PG8_MMA(0, 1, At, B1); PG8_BAR;
        PG8_LDA(At, 0, 1); PG8_STAGE(PG8_SA(0, 0), a2, voffA);
        PG8_BAR; PG8_WAIT_L(0); PG8_MMA(1, 0, At, B0); PG8_BAR; PG8_SCHED;
        PG8_STAGE(PG8_SB(0, 1), b2 + hstepB, voffB);
        PG8_WAIT_V(6); PG8_BAR; PG8_MMA(1, 1, At, B1); PG8_BAR;
        PG8_LDB(B0, 1, 0); PG8_SCHED; PG8_LDA(At, 1, 0); PG8_STAGE(PG8_SA(0, 1), a2 + hstepA, voffA);
        PG8_WAIT_L(8); PG8_BAR; PG8_WAIT_L(0); PG8_MMA(0, 0, At, B0); PG8_BAR; PG8_SCHED;
        PG8_LDB(B1, 1, 1); PG8_STAGE(PG8_SB(1, 0), b3, voffB);
        PG8_BAR; PG8_WAIT_L(0); PG8_MMA(0, 1, At, B1); PG8_BAR;
        PG8_LDA(At, 1, 1); PG8_STAGE(PG8_SA(1, 0), a3, voffA);
        PG8_BAR; PG8_WAIT_L(0); PG8_MMA(1, 0, At, B0); PG8_BAR; PG8_SCHED;
        PG8_STAGE(PG8_SB(1, 1), b3 + hstepB, voffB);
        PG8_WAIT_V(6); PG8_BAR; PG8_MMA(1, 1, At, B1); PG8_BAR;
      }
    }
    if constexpr (ALIGN_EPI) { if (wr == 0) PG8_BAR; }
    { const int le = fresh_lane(); E(acc, cur, wr, wc, le & 15, le >> 4); }
    if (!has_next) break;
#pragma unroll
    for (int a = 0; a < 2; ++a)
#pragma unroll
      for (int b = 0; b < 2; ++b)
#pragma unroll
        for (int m = 0; m < 4; ++m)
#pragma unroll
          for (int n = 0; n < 2; ++n) acc[a][b][m][n] = (f32x4){0.f, 0.f, 0.f, 0.f};
    cur = nxt; cA = nA; cB = nB; ++ui;
    if constexpr (ALIGN_EPI) { if (wr == 1) PG8_BAR; }
  }
  PG8_WAIT_V(0);
  if constexpr (!ALIGN_EPI) { if (wr == 0) PG8_BAR; }
  PG8_BAR;
#undef PG8_SA
#undef PG8_SB
#undef PG8_STAGE
#undef PG8_LDA
#undef PG8_LDB
#undef PG8_MMA
#undef PG8_WAIT_V
#undef PG8_WAIT_L
#undef PG8_BAR
#undef PG8_SCHED
}

typedef f32x4 Acc[2][2][4][2];
struct EpiSwiglu { static constexpr bool PERM = true; bf16_t* O;
  __device__ __forceinline__ void operator()(const Acc& acc, const Unit& u, int wr, int wc, int fr, int fq) const {
    const int row0 = u.pm * BM + wr * 64 + fr, col0 = u.pn * 128 + wc * 32 + 8 * fq;
#pragma unroll
    for (int ai = 0; ai < 2; ++ai)
#pragma unroll
      for (int m = 0; m < 4; ++m) { bf16_t* p = O + (size_t)(row0 + ai * HALF + m * 16) * DFF + col0; f32x4 r[2];
#pragma unroll
        for (int n = 0; n < 2; ++n)
#pragma unroll
          for (int j = 0; j < 4; ++j) { const float gv = acc[ai][0][m][n][j], uv = acc[ai][1][m][n][j]; r[n][j] = gv * fast_sigmoid(gv) * uv; }
        *(u32x4*)p = pack8(r[0], r[1]); }
  }
};
struct EpiResid { static constexpr bool PERM = false; const float* base; float* out; const float* gvec; float coef;
  __device__ __forceinline__ void operator()(const Acc& acc, const Unit& u, int wr, int wc, int fr, int fq) const {
    const int row0 = u.pm * BM + wr * 64 + fr, col0 = u.pn * BM + wc * 32 + 4 * fq; const float* g = gvec + (size_t)(u.pm >> 5) * NADA;
    f32x4 gv[2][2];
#pragma unroll
    for (int bj = 0; bj < 2; ++bj)
#pragma unroll
      for (int n = 0; n < 2; ++n) gv[bj][n] = *(const f32x4*)(g + col0 + bj * HALF + n * 16) * coef;
#pragma unroll
    for (int ai = 0; ai < 2; ++ai)
#pragma unroll
      for (int m = 0; m < 4; ++m) { const size_t off = (size_t)(row0 + ai * HALF + m * 16) * DM + col0;
#pragma unroll
        for (int bj = 0; bj < 2; ++bj)
#pragma unroll
          for (int n = 0; n < 2; ++n) { const f32x4 b = *(const f32x4*)(base + off + bj * HALF + n * 16); *(f32x4*)(out + off + bj * HALF + n * 16) = b + gv[bj][n] * acc[ai][bj][m][n]; } }
  }
};
struct EpiWin { static constexpr bool PERM = true; bf16_t *V, *GATES, *ZL, *KR; float *rsq_q, *rsq_kv; const float* rope;
  __device__ __forceinline__ void operator()(const Acc& acc, const Unit& u, int wr, int wc, int fr, int fq) const {
    const int row0 = u.pm * BM + wr * 64 + fr, cw = wc * 32 + 8 * fq;
    if (u.pn < 4) {
#pragma unroll
      for (int ai = 0; ai < 2; ++ai)
#pragma unroll
        for (int m = 0; m < 4; ++m)
#pragma unroll
          for (int bj = 0; bj < 2; ++bj) *(u32x4*)(V + (size_t)(row0 + ai * HALF + m * 16) * 1024 + u.pn * 256 + bj * HALF + cw) = pack8(acc[ai][bj][m][0], acc[ai][bj][m][1]);
    } else if (u.pn < 12) {
#pragma unroll
      for (int ai = 0; ai < 2; ++ai)
#pragma unroll
        for (int m = 0; m < 4; ++m)
#pragma unroll
          for (int bj = 0; bj < 2; ++bj) { f32x4 a = acc[ai][bj][m][0], b = acc[ai][bj][m][1];
#pragma unroll
            for (int j = 0; j < 4; ++j) { a[j] = fast_sigmoid(a[j]); b[j] = fast_sigmoid(b[j]); }
            *(u32x4*)(GATES + (size_t)(row0 + ai * HALF + m * 16) * 2048 + (u.pn - 4) * 256 + bj * HALF + cw) = pack8(a, b); }
    } else {
#pragma unroll
      for (int bj = 0; bj < 2; ++bj) { const int zc0 = (u.pn - 12) * 256 + bj * HALF;
        if (zc0 < 640) { float* rsq = zc0 < 384 ? rsq_q : rsq_kv;
#pragma unroll
          for (int ai = 0; ai < 2; ++ai)
#pragma unroll
            for (int m = 0; m < 4; ++m) { const int row = row0 + ai * HALF + m * 16; const f32x4 a = acc[ai][bj][m][0], b = acc[ai][bj][m][1];
              *(u32x4*)(ZL + (size_t)row * ZLW + zc0 + cw) = pack8(a, b);
              float ss = (a[0] * a[0] + a[1] * a[1]) + (a[2] * a[2] + a[3] * a[3]) + (b[0] * b[0] + b[1] * b[1]) + (b[2] * b[2] + b[3] * b[3]);
              ss += __shfl_xor(ss, 16); ss += __shfl_xor(ss, 32);
              if (fq == 0) __hip_atomic_fetch_add(rsq + row, ss, __ATOMIC_RELAXED, __HIP_MEMORY_SCOPE_AGENT); }
        } else if (wc == 0) {
#pragma unroll
          for (int ai = 0; ai < 2; ++ai)
#pragma unroll
            for (int m = 0; m < 4; ++m) { const int row = row0 + ai * HALF + m * 16; const f32x4 a = acc[ai][bj][m][0], b = acc[ai][bj][m][1];
              const f32x4 cs = *(const f32x4*)(rope + (size_t)row * 32 + 4 * fq), sn = *(const f32x4*)(rope + (size_t)row * 32 + 16 + 4 * fq);
              f32x4 oa, ob;
              oa[0] = a[0] * cs[0] - a[1] * sn[0]; oa[1] = a[1] * cs[0] + a[0] * sn[0]; oa[2] = a[2] * cs[1] - a[3] * sn[1]; oa[3] = a[3] * cs[1] + a[2] * sn[1];
              ob[0] = b[0] * cs[2] - b[1] * sn[2]; ob[1] = b[1] * cs[2] + b[0] * sn[2]; ob[2] = b[2] * cs[3] - b[3] * sn[3]; ob[3] = b[3] * cs[3] + b[2] * sn[3];
              *(u32x4*)(KR + (size_t)row * 32 + 8 * fq) = pack8(oa, ob); }
        }
      }
    }
  }
};
struct EpiQ { static constexpr bool PERM = true; bf16_t* Q; const float* rsq; const float* rope;
  __device__ __forceinline__ void operator()(const Acc& acc, const Unit& u, int wr, int wc, int fr, int fq) const {
    const int row0 = u.pm * BM + wr * 64 + fr;
#pragma unroll
    for (int ai = 0; ai < 2; ++ai)
#pragma unroll
      for (int m = 0; m < 4; ++m) { const unsigned row = (unsigned)(row0 + ai * HALF + m * 16); const float rs = rsqrtf(rsq[row] * (1.0f / QLR) + NORM_EPS);
#pragma unroll
        for (int bj = 0; bj < 2; ++bj) { const unsigned c0 = (unsigned)(u.pn * BM + bj * HALF + wc * 32 + 8 * fq), d = c0 % 96u;
          f32x4 a = acc[ai][bj][m][0] * rs, b = acc[ai][bj][m][1] * rs;
          if (d >= 64u) { const unsigned j0 = (d - 64u) >> 1; const f32x4 cs = *(const f32x4*)(rope + (row * 32u + j0)), sn = *(const f32x4*)(rope + (row * 32u + 16u + j0));
            f32x4 oa, ob;
            oa[0] = a[0] * cs[0] - a[1] * sn[0]; oa[1] = a[1] * cs[0] + a[0] * sn[0]; oa[2] = a[2] * cs[1] - a[3] * sn[1]; oa[3] = a[3] * cs[1] + a[2] * sn[1];
            ob[0] = b[0] * cs[2] - b[1] * sn[2]; ob[1] = b[1] * cs[2] + b[0] * sn[2]; ob[2] = b[2] * cs[3] - b[3] * sn[3]; ob[3] = b[3] * cs[3] + b[2] * sn[3];
            a = oa; b = ob; }
          *(u32x4*)(Q + (row * (unsigned)NQ + c0)) = pack8(a, b);
          asm volatile("" ::: "memory"); } }
  }
};
struct EpiKV { static constexpr bool PERM = true; bf16_t* KV; const float* rsq;
  __device__ __forceinline__ void operator()(const Acc& acc, const Unit& u, int wr, int wc, int fr, int fq) const {
    const int row0 = u.pm * BM + wr * 64 + fr;
#pragma unroll
    for (int ai = 0; ai < 2; ++ai)
#pragma unroll
      for (int m = 0; m < 4; ++m) { const int row = row0 + ai * HALF + m * 16; const float rs = rsqrtf(rsq[row] * (1.0f / KVLR) + NORM_EPS);
#pragma unroll
        for (int bj = 0; bj < 2; ++bj) { const int c0 = u.pn * BM + bj * HALF + wc * 32 + 8 * fq;
          *(u32x4*)(KV + (size_t)row * NKV + c0) = pack8(acc[ai][bj][m][0] * rs, acc[ai][bj][m][1] * rs); } }
  }
};
template <bool ADD, int GOFF> struct EpiMerge { static constexpr bool PERM = true; bf16_t* YM; const bf16_t* G;
  __device__ __forceinline__ void operator()(const Acc& acc, const Unit& u, int wr, int wc, int fr, int fq) const {
    const int row0 = u.pm * BM + wr * 64 + fr;
#pragma unroll
    for (int ai = 0; ai < 2; ++ai)
#pragma unroll
      for (int m = 0; m < 4; ++m) { const int row = row0 + ai * HALF + m * 16;
#pragma unroll
        for (int bj = 0; bj < 2; ++bj) { const int c0 = u.pn * BM + bj * HALF + wc * 32 + 8 * fq;
          const u32x4 gw = *(const u32x4*)(G + (size_t)row * 2048 + GOFF + c0);
          f32x4 a = acc[ai][bj][m][0], b = acc[ai][bj][m][1];
#ifndef DBG_NOGATE
          a[0] *= bf_lo(gw.x); a[1] *= bf_hi(gw.x); a[2] *= bf_lo(gw.y); a[3] *= bf_hi(gw.y); b[0] *= bf_lo(gw.z); b[1] *= bf_hi(gw.z); b[2] *= bf_lo(gw.w); b[3] *= bf_hi(gw.w);
#else
          a[0] += 1e-30f * bf_lo(gw.x);
#endif
          bf16_t* p = YM + (size_t)row * DM + c0;
          if (ADD) { const u32x4 t = *(const u32x4*)p;
            a[0] += bf_lo(t.x); a[1] += bf_hi(t.x); a[2] += bf_lo(t.y); a[3] += bf_hi(t.y); b[0] += bf_lo(t.z); b[1] += bf_hi(t.z); b[2] += bf_lo(t.w); b[3] += bf_hi(t.w); }
          *(u32x4*)p = pack8(a, b); } }
  }
};
}

namespace attn {
constexpr int SHM_V = 64 * 64 * 2, SHM_K = 64 * 256, LDS_BYTES = 2 * SHM_V + 2 * SHM_K + 8 * 64 * 4;
constexpr float THRL = 11.5f;
#define KSWZ(row, colB) ((row) * 256 + ((colB) ^ (((row) & 7) << 4)))
__device__ __forceinline__ int crow(int r, int hi) { return (r & 3) + 8 * (r >> 2) + 4 * hi; }
typedef short v4i16_t __attribute__((ext_vector_type(4)));
__device__ __forceinline__ s16x4 vtr(const LAS unsigned char* p) { return __builtin_bit_cast(s16x4, __builtin_amdgcn_ds_read_tr16_b64_v4i16((LAS v4i16_t*)p)); }
__device__ __forceinline__ int swap23(int k) { return (k & ~0xC) | ((k & 4) << 1) | ((k & 8) >> 1); }
__device__ __forceinline__ int v_rd_base(int lane) { return ((lane & 3) << 3) | (((lane >> 2) & 3) << 6) | (((lane >> 4) & 1) << 5) | (((lane >> 5) & 1) << 8); }
template <int NB> __device__ __forceinline__ int t_st(int k, int n) { const int kk = swap23(k); return ((kk >> 3) * NB + (n >> 5)) * 512 + ((kk & 7) * 32 + (n & 31)) * 2; }
template <int NB> __device__ __forceinline__ bf16x8 t_frag(const LAS unsigned char* base, int ks, int nb) {
  const s16x4 l = vtr(base + nb * 512 + ks * (1024 * NB)), h = vtr(base + nb * 512 + ks * (1024 * NB) + 512 * NB);
  return (bf16x8){l[0], l[1], l[2], l[3], h[0], h[1], h[2], h[3]};
}
__device__ __forceinline__ void partialSM(f32x16& p0, f32x16& p1, float& m_reg, float& mn, float& alpha) {
  float pmax = p0[0];
#pragma unroll
  for (int r = 1; r < 16; ++r) pmax = fmaxf(pmax, p0[r]);
#pragma unroll
  for (int r = 0; r < 16; ++r) pmax = fmaxf(pmax, p1[r]);
  { auto rr = __builtin_amdgcn_permlane32_swap(__float_as_uint(pmax), __float_as_uint(pmax), false, false);
    pmax = fmaxf(__uint_as_float(rr[0]), __uint_as_float(rr[1])); }
  if (__builtin_expect(__all(pmax - m_reg <= THRL), 1)) { mn = m_reg; alpha = 1.f; }
  else { mn = fmaxf(m_reg, pmax); alpha = __builtin_amdgcn_exp2f(m_reg - mn); m_reg = mn; }
#pragma unroll
  for (int r = 0; r < 16; ++r) { p0[r] -= mn; p1[r] -= mn; }
#pragma unroll
  for (int r = 0; r < 16; ++r) p0[r] = __builtin_amdgcn_exp2f(p0[r]);
}
__device__ __forceinline__ void finishSM(f32x16& p0, f32x16& p1, float alpha, float& l_reg, bf16x8& pa0, bf16x8& pa1, bf16x8& pa2, bf16x8& pa3) {
#pragma unroll
  for (int r = 0; r < 16; ++r) p1[r] = __builtin_amdgcn_exp2f(p1[r]);
  float ps = 0;
#pragma unroll
  for (int r = 0; r < 16; ++r) ps += p0[r];
#pragma unroll
  for (int r = 0; r < 16; ++r) ps += p1[r];
  { auto rr = __builtin_amdgcn_permlane32_swap(__float_as_uint(ps), __float_as_uint(ps), false, false);
    ps = __uint_as_float(rr[0]) + __uint_as_float(rr[1]); }
  l_reg = l_reg * alpha + ps;
#define PK4(P, BASE, OUT) do { unsigned a0 = cvt_pk_bf16(P[BASE + 0], P[BASE + 1]), a1 = cvt_pk_bf16(P[BASE + 2], P[BASE + 3]);   \
    unsigned b0 = cvt_pk_bf16(P[BASE + 4], P[BASE + 5]), b1 = cvt_pk_bf16(P[BASE + 6], P[BASE + 7]);                              \
    auto r0 = __builtin_amdgcn_permlane32_swap(a0, b0, false, false); auto r1 = __builtin_amdgcn_permlane32_swap(a1, b1, false, false); \
    u32x4 w = {r0[0], r1[0], r0[1], r1[1]}; OUT = __builtin_bit_cast(bf16x8, w); } while (0)
  PK4(p0, 0, pa0); PK4(p0, 8, pa1); PK4(p1, 0, pa2); PK4(p1, 8, pa3);
#undef PK4
}
__device__ __forceinline__ void qkt(f32x16& p0, f32x16& p1, const LAS unsigned char* Ks, const bf16x8* qr, int r32, int hi) {
  p0 = f32x16{}; p1 = f32x16{};
#pragma unroll
  for (int d0 = 0; d0 < 6; ++d0) { const int cb = (d0 * 16 + hi * 8) * 2;
    const bf16x8 b0 = *(const LAS bf16x8*)(Ks + KSWZ(r32, cb));
    const bf16x8 b1 = *(const LAS bf16x8*)(Ks + KSWZ(32 + r32, cb));
    p0 = __builtin_amdgcn_mfma_f32_32x32x16_bf16(b0, qr[d0], p0, 0, 0, 0);
    p1 = __builtin_amdgcn_mfma_f32_32x32x16_bf16(b1, qr[d0], p1, 0, 0, 0); }
}
__device__ __forceinline__ void pv2(f32x16* o, const LAS unsigned char* vb, bf16x8 pa0, bf16x8 pa1, bf16x8 pa2, bf16x8 pa3) {
#pragma unroll
  for (int d0 = 0; d0 < 2; ++d0) {
    const bf16x8 v0 = t_frag<2>(vb, 0, d0), v1 = t_frag<2>(vb, 1, d0), v2 = t_frag<2>(vb, 2, d0), v3 = t_frag<2>(vb, 3, d0);
    o[d0] = __builtin_amdgcn_mfma_f32_32x32x16_bf16(pa0, v0, o[d0], 0, 0, 0);
    o[d0] = __builtin_amdgcn_mfma_f32_32x32x16_bf16(pa1, v1, o[d0], 0, 0, 0);
    o[d0] = __builtin_amdgcn_mfma_f32_32x32x16_bf16(pa2, v2, o[d0], 0, 0, 0);
    o[d0] = __builtin_amdgcn_mfma_f32_32x32x16_bf16(pa3, v3, o[d0], 0, 0, 0);
  }
}
__device__ __forceinline__ unsigned f2bf(float f) { unsigned u = __float_as_uint(f); return (u + 0x7fffu + ((u >> 16) & 1u)) >> 16; }

__device__ __forceinline__ void attn_unit(int b, int h, int qb, const bf16_t* __restrict__ Q, const bf16_t* __restrict__ KV, const bf16_t* __restrict__ KR, bf16_t* __restrict__ O, LAS unsigned char* lds, const int wid) {
  const int lane = fresh_lane(), tid = wid * 64 + lane, r32 = lane & 31, hi = lane >> 5;
  LAS unsigned char* V_lds = lds; LAS unsigned char* K_lds = lds + 2 * SHM_V;
  LAS float* ws = (LAS float*)(lds + 2 * SHM_V + 2 * SHM_K) + wid * 64; LAS float* li_l = ws; LAS float* al_l = ws + 32;
  float m_reg = -1e30f, l_reg = 0; f32x16 o[2] = {}; bf16x8 qr[6];
  const size_t tok0 = (size_t)b * SEQ;
  const bf16_t* Qw = Q + (tok0 + qb * 256 + wid * 32 + r32) * NQ + h * 96 + hi * 8;
#pragma unroll
  for (int d0 = 0; d0 < 6; ++d0) qr[d0] = *(const bf16x8*)(Qw + d0 * 16);
  const int srow = tid >> 3, sch = tid & 7;
  const bf16_t* kp = KV + (tok0 + srow) * NKV + h * 128 + sch * 8; const bf16_t* vp = kp + 64; const bf16_t* rp = KR + (tok0 + srow) * 32 + sch * 4;
  const int kst = KSWZ(srow, sch * 16), vst = t_st<2>(srow, sch * 8), rst = KSWZ(srow, 128 + (sch >> 1) * 16) + (sch & 1) * 8;
  const LAS unsigned char* vb0 = V_lds + v_rd_base(lane);
  bf16x8 ksA, vsA, ksB, vsB; u32x2 rsA, rsB;
#define SLOAD(S, k0) do { ks##S = *(const bf16x8*)(kp + (size_t)(k0) * NKV); vs##S = *(const bf16x8*)(vp + (size_t)(k0) * NKV); rs##S = *(const u32x2*)(rp + (size_t)(k0) * 32); } while (0)
#define SWRITE(bf, S) do { *(LAS bf16x8*)(K_lds + (bf) * SHM_K + kst) = ks##S; *(LAS bf16x8*)(V_lds + (bf) * SHM_V + vst) = vs##S; *(LAS u32x2*)(K_lds + (bf) * SHM_K + rst) = rs##S; } while (0)
#define SWAIT() asm volatile("s_waitcnt vmcnt(3)" ::: "memory")
#define RESC(a) do { if (__any((a) < 1.f)) { if (hi == 0) al_l[r32] = (a); LDS_WAIT(); \
    _Pragma("unroll") for (int d = 0; d < 2; ++d) _Pragma("unroll") for (int r = 0; r < 16; ++r) o[d][r] *= al_l[crow(r, hi)]; } } while (0)
#define SBAR() __builtin_amdgcn_sched_barrier(0)
  f32x16 pA0, pA1, pB0, pB1; float mnA, mnB, alA, alB; bf16x8 pa0, pa1, pa2, pa3; constexpr int NT = SEQ / 64;
  SLOAD(A, 0); VM_WAIT(); SWRITE(0, A); __syncthreads();
  qkt(pA0, pA1, K_lds, qr, r32, hi); partialSM(pA0, pA1, m_reg, mnA, alA);
  SLOAD(B, 64); SLOAD(A, 128);
  SWAIT(); SWRITE(1, B); __syncthreads();
  for (int j = 1; j + 1 < NT; j += 2) {
    SBAR(); qkt(pB0, pB1, K_lds + SHM_K, qr, r32, hi);
    finishSM(pA0, pA1, alA, l_reg, pa0, pa1, pa2, pa3); SBAR();
    SLOAD(B, (j + 2) * 64); SBAR();
    pv2(o, vb0, pa0, pa1, pa2, pa3); partialSM(pB0, pB1, m_reg, mnB, alB);
    __syncthreads(); SWAIT(); SWRITE(0, A);
    RESC(alB); __syncthreads();
    SBAR(); qkt(pA0, pA1, K_lds, qr, r32, hi);
    finishSM(pB0, pB1, alB, l_reg, pa0, pa1, pa2, pa3); SBAR();
    if (j + 3 < NT) SLOAD(A, (j + 3) * 64); SBAR();
    pv2(o, vb0 + SHM_V, pa0, pa1, pa2, pa3); partialSM(pA0, pA1, m_reg, mnA, alA);
    __syncthreads(); SWAIT(); SWRITE(1, B);
    RESC(alA); __syncthreads();
  }
  SBAR(); qkt(pB0, pB1, K_lds + SHM_K, qr, r32, hi);
  finishSM(pA0, pA1, alA, l_reg, pa0, pa1, pa2, pa3); SBAR();
  pv2(o, vb0, pa0, pa1, pa2, pa3); partialSM(pB0, pB1, m_reg, mnB, alB);
  __syncthreads(); RESC(alB);
  finishSM(pB0, pB1, alB, l_reg, pa0, pa1, pa2, pa3); SBAR();
  pv2(o, vb0 + SHM_V, pa0, pa1, pa2, pa3);
  if (hi == 0) li_l[r32] = l_reg; LDS_WAIT();
  float rli[16];
#pragma unroll
  for (int r = 0; r < 16; ++r) rli[r] = __builtin_amdgcn_rcpf(li_l[crow(r, hi)]);
  bf16_t* Ow = O + (tok0 + qb * 256 + wid * 32) * 512 + h * 64;
#pragma unroll
  for (int r = 0; r < 16; ++r) { const int orow = crow(r, hi);
#pragma unroll
    for (int d0 = 0; d0 < 2; ++d0) Ow[(size_t)orow * 512 + d0 * 32 + r32] = (bf16_t)f2bf(o[d0][r] * rli[r]); }
  VM_WAIT(); __syncthreads();
#undef SLOAD
#undef SWRITE
#undef SWAIT
#undef RESC
#undef SBAR
}
}

namespace fft {
using attn::crow; using attn::t_st; using attn::t_frag; using attn::v_rd_base; using attn::f2bf;
__device__ __forceinline__ int am64(int row, int k) { return row * 128 + ((((k >> 3) ^ (row & 7))) << 4) + (k & 7) * 2; }
__device__ __forceinline__ int am128(int row, int k) { return row * 256 + ((((k >> 3) ^ (row & 15))) << 4) + (k & 7) * 2; }
constexpr int T_OFF = 0, A_OFF = 65536, TWL_OFF = 65536 + 24576;
__device__ __forceinline__ void stage1(const bf16_t* __restrict__ V, bf16_t* __restrict__ Y, const bf16_t* __restrict__ c64  , const float* __restrict__ tw, LAS unsigned char* lds, int first, int stride, const int wid) {
  const int lane = fresh_lane(), tid = wid * 64 + lane, r32 = lane & 31, hi = lane >> 5;
  LAS unsigned char* T = lds + T_OFF; LAS unsigned char* A = lds + A_OFF; LAS f32x2* twl = (LAS f32x2*)(lds + TWL_OFF);
#pragma unroll
  for (int i = 0; i < 3; ++i) { const int idx = tid + 512 * i, mi = idx >> 9, ch = idx & 511, row = ch >> 3, kc = ch & 7;
    *(LAS u32x4*)(A + mi * 8192 + am64(row, kc * 8)) = *(const u32x4*)(c64 + mi * 4096 + row * 64 + kc * 8); }
  u32x4 st[8];
#define F1_LOAD(u) do { const int b_ = (u) >> 8, b2_ = ((u) >> 1) & 127, hf_ = (u) & 1; \
    _Pragma("unroll") for (int i = 0; i < 8; ++i) { const int idx = tid + 512 * i, a = idx >> 6, n = (idx & 63) * 8; const int gcol = (n < 256) ? hf_ * 256 + n : 512 + hf_ * 256 + (n - 256); \
      st[i] = *(const u32x4*)(V + ((size_t)b_ * SEQ + 128 * a + b2_) * 1024 + gcol); } } while (0)
  int u = first; if (u >= 1024) return;
  F1_LOAD(u);
  for (;;) {
    const int b = u >> 8, b2 = (u >> 1) & 127, hf = u & 1;
#pragma unroll
    for (int i = 0; i < 8; ++i) { const int idx = tid + 512 * i, a = idx >> 6, n = (idx & 63) * 8; *(LAS u32x4*)(T + t_st<16>(a, n)) = st[i]; }
    if (tid < 64) twl[tid] = *(const f32x2*)(tw + ((size_t)tid * 128 + b2) * 2);
    __syncthreads();
    const int un = u + stride; if (un < 1024) F1_LOAD(un);
    const LAS unsigned char* tb = T + v_rd_base(lane);
    {
      asm volatile("" ::: "memory");
      const int nbr = wid, nbi = 8 + wid;
      f32x16 ar[2] = {}, ai[2] = {};
#pragma unroll
      for (int ks = 0; ks < 4; ++ks) {
        const bf16x8 Br = t_frag<16>(tb, ks, nbr), Bi = t_frag<16>(tb, ks, nbi);
#pragma unroll
        for (int mb = 0; mb < 2; ++mb) { const int off = am64(32 * mb + r32, 16 * ks + 8 * hi);
          const bf16x8 Ac = *(const LAS bf16x8*)(A + off), As = *(const LAS bf16x8*)(A + 8192 + off), An = *(const LAS bf16x8*)(A + 16384 + off);
          ar[mb] = __builtin_amdgcn_mfma_f32_32x32x16_bf16(Ac, Br, ar[mb], 0, 0, 0); ar[mb] = __builtin_amdgcn_mfma_f32_32x32x16_bf16(As, Bi, ar[mb], 0, 0, 0);
          ai[mb] = __builtin_amdgcn_mfma_f32_32x32x16_bf16(Ac, Bi, ai[mb], 0, 0, 0); ai[mb] = __builtin_amdgcn_mfma_f32_32x32x16_bf16(An, Br, ai[mb], 0, 0, 0); }
      }
      const int colr = hf * 256 + 32 * wid + r32;
#pragma unroll
      for (int mb = 0; mb < 2; ++mb)
#pragma unroll
        for (int r = 0; r < 16; ++r) { const int c = 32 * mb + crow(r, hi); const f32x2 t = twl[c]; const float yr = ar[mb][r], yi = ai[mb][r];
          bf16_t* dst = Y + (((size_t)b * 64 + c) * 128 + b2) * 1024 + colr;
          dst[0] = (bf16_t)f2bf(yr * t.x + yi * t.y); dst[512] = (bf16_t)f2bf(yi * t.x - yr * t.y); }
    }
    __syncthreads();
    if (un >= 1024) break; u = un;
  }
#undef F1_LOAD
}
__device__ __forceinline__ void stage2(const bf16_t* __restrict__ Y, bf16_t* __restrict__ F, const bf16_t* __restrict__ c128  , LAS unsigned char* lds, int first, int stride, const int wid) {
  const int lane = fresh_lane(), tid = wid * 64 + lane, r32 = lane & 31, hi = lane >> 5;
  LAS unsigned char* T = lds + T_OFF; LAS unsigned char* A = lds + A_OFF;
#pragma unroll
  for (int i = 0; i < 8; ++i) { const int idx = tid + 512 * i, mi = idx >> 11, ch = idx & 2047, row = ch >> 4, kc = ch & 15;
    *(LAS u32x4*)(A + mi * 32768 + am128(row, kc * 8)) = *(const u32x4*)(c128 + mi * 16384 + row * 128 + kc * 8); }
  u32x4 st[8];
#define F2_LOAD(u) do { const int b_ = (u) >> 8, c_ = ((u) >> 2) & 63, qt_ = (u) & 3; \
    _Pragma("unroll") for (int i = 0; i < 8; ++i) { const int idx = tid + 512 * i, row = idx >> 5, n = (idx & 31) * 8; const int gcol = (n < 128) ? qt_ * 128 + n : 512 + qt_ * 128 + (n - 128); \
      st[i] = *(const u32x4*)(Y + (((size_t)b_ * 64 + c_) * 128 + row) * 1024 + gcol); } } while (0)
  int u = first; if (u >= 1024) return;
  F2_LOAD(u);
  for (;;) {
    const int b = u >> 8, c = (u >> 2) & 63, qt = u & 3;
#pragma unroll
    for (int i = 0; i < 8; ++i) { const int idx = tid + 512 * i, row = idx >> 5, n = (idx & 31) * 8; *(LAS u32x4*)(T + t_st<8>(row, n)) = st[i]; }
    __syncthreads();
    const int un = u + stride; if (un < 1024) F2_LOAD(un);
    const LAS unsigned char* tb = T + v_rd_base(lane);
    const int nb = wid & 3, mh = wid >> 2;
    asm volatile("" ::: "memory");
    f32x16 acc[2] = {};
#pragma unroll
    for (int ks = 0; ks < 8; ++ks) {
      const bf16x8 Br = t_frag<8>(tb, ks, nb), Bi = t_frag<8>(tb, ks, 4 + nb);
#pragma unroll
      for (int mb = 0; mb < 2; ++mb) { const int off = am128(64 * mh + 32 * mb + r32, 16 * ks + 8 * hi);
        const bf16x8 Ac = *(const LAS bf16x8*)(A + off), As = *(const LAS bf16x8*)(A + 32768 + off);
        acc[mb] = __builtin_amdgcn_mfma_f32_32x32x16_bf16(Ac, Br, acc[mb], 0, 0, 0); acc[mb] = __builtin_amdgcn_mfma_f32_32x32x16_bf16(As, Bi, acc[mb], 0, 0, 0); }
    }
#pragma unroll
    for (int mb = 0; mb < 2; ++mb)
#pragma unroll
      for (int r = 0; r < 16; ++r) { const int d = 64 * mh + 32 * mb + crow(r, hi);
        F[((size_t)b * SEQ + c + 64 * d) * 512 + qt * 128 + 32 * nb + r32] = (bf16_t)f2bf(acc[mb][r]); }
    __syncthreads();
    if (un >= 1024) break; u = un;
  }
#undef F2_LOAD
}
}

#define XB_TMO      128
#define XB_XCNT(j)  (256  + 64 * (j))
#define XB_XSUB(j)  (1280 + 64 * (j))
#define XB_XGEN(j)  (2304 + 64 * (j))
#define XB_TOP      3328
#define XB_TOPGEN   3392
#define XCD_BAR_WORDS 3456
#define XB_SPIN_CAP (1u << 18)
__device__ __forceinline__ unsigned xb_ld(unsigned* p)              { return __hip_atomic_load(p, __ATOMIC_RELAXED, __HIP_MEMORY_SCOPE_AGENT); }
__device__ __forceinline__ unsigned xb_add(unsigned* p, unsigned v) { return __hip_atomic_fetch_add(p, v, __ATOMIC_RELAXED, __HIP_MEMORY_SCOPE_AGENT); }
__device__ __forceinline__ unsigned xb_xcc_id() { return (unsigned)__builtin_amdgcn_s_getreg((3 << 11) | 20) & 0xFu; }
#define XB_SPIN(cond, bar) do { unsigned _sp = 0; while (cond) { __builtin_amdgcn_s_sleep(1); \
    if ((++_sp & 255u) == 0u) { if (xb_ld(&(bar)[XB_TMO])) break; if (_sp > XB_SPIN_CAP) { atomicAdd(&(bar)[XB_TMO], 1u); break; } } } } while (0)
struct XcdBarrier { unsigned* bar; unsigned x; volatile LAS unsigned* st; };
__device__ __forceinline__ XcdBarrier xcd_barrier_post(unsigned* bar, volatile LAS unsigned* st) {
  XcdBarrier b; b.bar = bar; b.x = xb_xcc_id(); b.st = st;
  if (threadIdx.x == 0) (void)xb_add(&bar[XB_XCNT(b.x)], 1u);
  return b;
}
__device__ __forceinline__ void xcd_barrier_complete(unsigned* bar, unsigned x, unsigned& nloc, unsigned& nx) {
  const unsigned G = gridDim.x * gridDim.y * gridDim.z;
  unsigned sum, cnt, mine, sp = 0u;
  for (;;) {
    sum = 0u; cnt = 0u; mine = 0u;
#pragma unroll
    for (unsigned j = 0; j < 16; ++j) { const unsigned c = xb_ld(&bar[XB_XCNT(j)]); sum += c; cnt += (c > 0u) ? 1u : 0u; mine = (j == x) ? c : mine; }
    if (sum == G) break;
    __builtin_amdgcn_s_sleep(1);
    if ((++sp & 255u) == 0u) { if (xb_ld(&bar[XB_TMO])) break; if (sp > XB_SPIN_CAP) { atomicAdd(&bar[XB_TMO], 1u); break; } }
  }
  nloc = mine > 0u ? mine : 1u; nx = cnt > 0u ? cnt : 1u;
}
__device__ __forceinline__ void xcd_barrier(const XcdBarrier& b) {
  asm volatile("s_waitcnt vmcnt(0)" ::: "memory");
  __syncthreads();
  if (threadIdx.x == 0) {
    unsigned* bar = b.bar;
    __builtin_amdgcn_s_waitcnt(0);
    unsigned nloc = b.st[0], nx = b.st[1];
    if (nloc == 0u) { xcd_barrier_complete(bar, b.x, nloc, nx); b.st[0] = nloc; b.st[1] = nx; }
    const unsigned old = xb_add(&bar[XB_XSUB(b.x)], 1u);
    const unsigned gen = old / nloc;
    if (old + 1u == (gen + 1u) * nloc) {
      __builtin_amdgcn_fence(__ATOMIC_RELEASE, "agent");
      asm volatile("s_waitcnt vmcnt(0)" ::: "memory");
      const unsigned og = xb_add(&bar[XB_TOP], 1u);
      const unsigned tg = og / nx;
      if (og + 1u == (tg + 1u) * nx) xb_add(&bar[XB_TOPGEN], 1u);
      else XB_SPIN(xb_ld(&bar[XB_TOPGEN]) == tg, bar);
      __builtin_amdgcn_fence(__ATOMIC_ACQUIRE, "agent");
      xb_add(&bar[XB_XGEN(b.x)], 1u);
      asm volatile("s_waitcnt vmcnt(0)" ::: "memory");
    } else {
      XB_SPIN(xb_ld(&bar[XB_XGEN(b.x)]) == gen, bar);
      __builtin_amdgcn_fence(__ATOMIC_ACQUIRE, "agent");
      asm volatile("s_waitcnt vmcnt(0)" ::: "memory");
    }
  }
  __syncthreads();
}

constexpr int NWAVES = 8;
constexpr int RING_BYTES = 131072, LDSCTL_OFF = RING_BYTES, MISC_OFF = LDSCTL_OFF + 320, FOLD_OFF = RING_BYTES + 1024;
constexpr int LDS_BYTES = 147456;
struct Args { const float* in[23]; float* out; unsigned char* ws; int ph_lo, ph_hi; };
struct Frame {
  LAS unsigned char* lds; int wave, vcu, G;
  const float* const* in; float* out; unsigned char* ws;
};

__device__ __forceinline__ void p0_transpose_item(const float* __restrict__ W, int ldw, int k0, int n0, bf16_t* __restrict__ WT, int ldwt, int drow0, bool perm, const float* __restrict__ kscale, float cscale, LAS float* scr, int lane) {
#pragma unroll 8
  for (int i = 0; i < 32; ++i) { const int kk = 2 * i + (lane >> 5); float v = W[(size_t)(k0 + kk) * ldw + n0 + (lane & 31)]; if (kscale) v *= kscale[k0 + kk]; scr[kk * 33 + (lane & 31)] = v * cscale; }
  LDS_WAIT(); asm volatile("" ::: "memory");
  const int c = lane & 7;
#pragma unroll
  for (int j = 0; j < 4; ++j) { const int n = (lane >> 3) + 8 * j; const LAS float* s = scr + (8 * c) * 33 + n;
    u32x4 o; o.x = cvt_pk_bf16(s[0 * 33], s[1 * 33]); o.y = cvt_pk_bf16(s[2 * 33], s[3 * 33]); o.z = cvt_pk_bf16(s[4 * 33], s[5 * 33]); o.w = cvt_pk_bf16(s[6 * 33], s[7 * 33]);
    const int dr = drow0 + (perm ? (n < 16 ? 2 * n : 2 * (n - 16) + 1) : n);
    *(u32x4*)(WT + (size_t)dr * ldwt + k0 + 8 * c) = o; }
  LDS_WAIT(); asm volatile("" ::: "memory");
}
constexpr int I_GU = 16 * 88, I_DN = 44 * 32, I_WIN = 16 * 85, I_WQ = 6 * 24, I_WKV = 4 * 32, I_WF = 8 * 32, I_WO = 16 * 32;
constexpr int NTRANS = 4 * I_GU + 2 * I_DN + I_WIN + I_WQ + I_WKV + 2 * I_WF + I_WO;
constexpr int NMODI = 144 * 32;
__device__ __forceinline__ void p0_trans_dispatch(const Frame& F, int r, LAS float* scr) {
  unsigned char* ws = F.ws; const int lane = fresh_lane();
  if (r < 4 * I_GU) { const int j = r / I_GU, it = r % I_GU, kb = it / 88, nb = it % 88, n0 = nb * 32;
    const float* W = j == 0 ? F.in[6] : j == 1 ? F.in[7] : j == 2 ? F.in[19] : F.in[20]; bf16_t* WT = (bf16_t*)(ws + (j < 2 ? WS_WGU1 : WS_WGU2));
    p0_transpose_item(W, DFF, kb * 64, n0, WT, DM, (n0 >> 7) * 256 + (j & 1) * 128 + (n0 & 127), false, nullptr, 1.f, scr, lane); return; }
  r -= 4 * I_GU;
  if (r < 2 * I_DN) { const int j = r / I_DN, it = r % I_DN, kb = it / 32, nb = it % 32;
    p0_transpose_item(j ? F.in[21] : F.in[8], DM, kb * 64, nb * 32, (bf16_t*)(ws + (j ? WS_WD2 : WS_WD1)), DFF, nb * 32, false, nullptr, 1.f, scr, lane); return; }
  r -= 2 * I_DN;
  if (r < I_WIN) { const int kb = r / 85, nb = r % 85, n0 = 512 + nb * 32; int dr; bool perm = false;
    if (n0 < 896) dr = 3072 + (n0 - 512); else if (n0 < 1152) dr = 3456 + (n0 - 896); else if (n0 < 1184) { dr = 3712; perm = true; } else dr = 1024 + (n0 - 1184);
    p0_transpose_item(F.in[10], 3232, kb * 64, n0, (bf16_t*)(ws + WS_WIN), DM, dr, perm, nullptr, 1.f, scr, lane); return; }
  r -= I_WIN;
  if (r < I_WQ) { const int kb = r / 24, nb = r % 24, n0 = nb * 32;
    p0_transpose_item(F.in[12], NQ, kb * 64, n0, (bf16_t*)(ws + WS_WQ), QLR, n0, (n0 % 96) == 64, F.in[11], SCQ, scr, lane); return; }
  r -= I_WQ;
  if (r < I_WKV) { const int kb = r / 32, nb = r % 32;
    p0_transpose_item(F.in[14], NKV, kb * 64, nb * 32, (bf16_t*)(ws + WS_WKV), KVLR, nb * 32, false, F.in[13], 1.f, scr, lane); return; }
  r -= I_WKV;
  if (r < 2 * I_WF) { const int j = r / I_WF, it = r % I_WF, kb = it / 32, nb = it % 32;
    p0_transpose_item(j ? F.in[16] : F.in[15], DM, kb * 64, nb * 32, (bf16_t*)(ws + (j ? WS_WM : WS_WF)), 512, nb * 32, false, nullptr, 1.f, scr, lane); return; }
  r -= 2 * I_WF;
  { const int kb = r / 32, nb = r % 32;
    p0_transpose_item(F.in[17], DM, kb * 64, nb * 32, (bf16_t*)(ws + WS_WO), DM, nb * 32, false, nullptr, 1.f, scr, lane); }
}
__device__ __forceinline__ void p0_mod_item(const Frame& F, int it) {
  const int nb = it % 144, kc = it / 144, n = nb * 64 + fresh_lane(); const float* cin = F.in[1]; const float* W = F.in[3] + (size_t)(kc * 32) * NADA + n;
  float acc[4] = {0.f, 0.f, 0.f, 0.f};
#pragma unroll 8
  for (int kk = 0; kk < 32; ++kk) { const float w = W[(size_t)kk * NADA];
#pragma unroll
    for (int b = 0; b < 4; ++b) { const float cv = cin[b * DM + kc * 32 + kk]; acc[b] += cv * fast_sigmoid(cv) * w; } }
  float* mod = (float*)(F.ws + OFF_MOD);
#pragma unroll
  for (int b = 0; b < 4; ++b) { float v = acc[b]; if (kc == 0) v += F.in[4][n]; __hip_atomic_fetch_add(mod + b * NADA + n, v, __ATOMIC_RELAXED, __HIP_MEMORY_SCOPE_AGENT); }
}
__device__ __forceinline__ void p0_fold_item(const Frame& F, int it) {
  LAS float* tile = (LAS float*)(F.lds + FOLD_OFF); LAS float* cosT = tile + 2048;
  const int kc = it >> 2, g = it & 3, k0 = kc * 16, tid = F.wave * 64 + fresh_lane();
  { const int idx = tid * 4, kk = idx >> 7, c = idx & 127; *(LAS f32x4*)(tile + idx) = *(const f32x4*)(F.in[10] + (size_t)(k0 + kk) * 3232 + g * 128 + c); }
  if (tid < 128) cosT[tid] = __builtin_amdgcn_cosf((float)tid * (1.0f / 128.0f)) * 0.08838834764831845f;
  __syncthreads();
  const int n = tid & 255, ri = n >> 7, m = n & 127, kh = tid >> 8;
  float acc[8] = {0.f, 0.f, 0.f, 0.f, 0.f, 0.f, 0.f, 0.f};
  for (int c = 0; c < 128; ++c) { const int idx = (m * c) & 127; const float tv = ri ? -cosT[(idx - 32) & 127] : cosT[idx];
#pragma unroll
    for (int q = 0; q < 8; ++q) acc[q] += tile[(kh * 8 + q) * 128 + c] * tv; }
  u32x4 o; o.x = cvt_pk_bf16(acc[0], acc[1]); o.y = cvt_pk_bf16(acc[2], acc[3]); o.z = cvt_pk_bf16(acc[4], acc[5]); o.w = cvt_pk_bf16(acc[6], acc[7]);
  *(u32x4*)((bf16_t*)(F.ws + WS_WIN) + (size_t)(ri * 512 + g * 128 + m) * DM + k0 + kh * 8) = o;
  __syncthreads();
}
__device__ __forceinline__ void p0_prologue(const Frame& F) {
  unsigned char* ws = F.ws;
  for (int it = blockIdx.x; it < 256; it += F.G) p0_fold_item(F, it);
  LAS float* scr = (LAS float*)(F.lds + F.wave * 16384);
  const int gw = F.vcu * NWAVES + F.wave, NGW = F.G * NWAVES;
  for (int it = gw; it < NMODI; it += NGW) p0_mod_item(F, it);
  for (int it = gw; it < NTRANS; it += NGW) p0_trans_dispatch(F, it, scr);
  const int gt = blockIdx.x * 512 + F.wave * 64 + fresh_lane(), NGT = F.G * 512;
  { const int* pos = (const int*)F.in[2]; float* rope = (float*)(ws + WS_ROPE);
    for (int e = gt; e < MTOK * 16; e += NGT) { const int tok = e >> 4, j = e & 15;
      const double c4 = (j & 3) == 0 ? 1.0 : (j & 3) == 1 ? 0.5623413251903491 : (j & 3) == 2 ? 0.31622776601683794 : 0.1778279410038923;
      const double p10 = (j >> 2) == 0 ? 1.0 : (j >> 2) == 1 ? 0.1 : (j >> 2) == 2 ? 0.01 : 0.001;
      const float inv = (float)(c4 * p10); const float ang = (float)pos[tok] * inv;
      double t = (double)ang * 0.15915494309189535; t -= __builtin_floor(t); const float tf = (float)t;
      rope[(size_t)tok * 32 + j] = __builtin_amdgcn_cosf(tf); rope[(size_t)tok * 32 + 16 + j] = __builtin_amdgcn_sinf(tf); } }
  { float* tw = (float*)(ws + WS_TW);
    for (int e = gt; e < 64 * 128; e += NGT) { const int c = e >> 7, b2 = e & 127; const float t = (float)((c * b2) & 8191) * (1.0f / 8192.0f);
      tw[2 * e] = __builtin_amdgcn_cosf(t); tw[2 * e + 1] = __builtin_amdgcn_sinf(t); } }
  { bf16_t* c64 = (bf16_t*)(ws + WS_C64);
    for (int e = gt; e < 4096; e += NGT) { const int c = e >> 6, a = e & 63; const float t = (float)((c * a) & 63) * (1.0f / 64.0f);
      const float cs = __builtin_amdgcn_cosf(t) * 0.125f, sn = __builtin_amdgcn_sinf(t) * 0.125f;
      c64[e] = (bf16_t)attn::f2bf(cs); c64[4096 + e] = (bf16_t)attn::f2bf(sn); c64[8192 + e] = (bf16_t)attn::f2bf(-sn); } }
  { bf16_t* c128 = (bf16_t*)(ws + WS_C128);
    for (int e = gt; e < 16384; e += NGT) { const int d = e >> 7, b2 = e & 127; const float t = (float)((d * b2) & 127) * (1.0f / 128.0f);
      c128[e] = (bf16_t)attn::f2bf(__builtin_amdgcn_cosf(t) * 0.08838834764831845f); c128[16384 + e] = (bf16_t)attn::f2bf(__builtin_amdgcn_sinf(t) * 0.08838834764831845f); } }
  { u32x4* z = (u32x4*)((bf16_t*)(ws + WS_WIN) + (size_t)3744 * DM);
    for (int e = gt; e < 96 * DM / 8; e += NGT) z[e] = (u32x4){0u, 0u, 0u, 0u}; }
}
__device__ __forceinline__ void norm_mod_phase(const Frame& F, const float* __restrict__ x, const float* __restrict__ g, const float* __restrict__ mod_shift, const float* __restrict__ mod_scale, bf16_t* __restrict__ H) {
  const int gw = F.vcu * NWAVES + F.wave, NGW = F.G * NWAVES, lane = fresh_lane();
  for (int ch = gw; ch < MTOK / 16; ch += NGW) {
    const int row0 = ch * 16, b = row0 / SEQ;
    f32x4 av[4], bv[4];
#pragma unroll
    for (int j = 0; j < 4; ++j) { const int col = 4 * lane + 256 * j; const f32x4 gg = *(const f32x4*)(g + col), sc = *(const f32x4*)(mod_scale + (size_t)b * NADA + col);
      av[j] = gg * (1.0f + sc); bv[j] = *(const f32x4*)(mod_shift + (size_t)b * NADA + col); }
    for (int r = 0; r < 16; ++r) {
      const f32x4* xr = (const f32x4*)(x + (size_t)(row0 + r) * DM) + lane; f32x4 v[4]; float s = 0.f;
#pragma unroll
      for (int j = 0; j < 4; ++j) { v[j] = xr[64 * j]; s += (v[j][0] * v[j][0] + v[j][1] * v[j][1]) + (v[j][2] * v[j][2] + v[j][3] * v[j][3]); }
      const float rs = rsqrtf(wave_sum(s) * (1.0f / DM) + NORM_EPS);
      u32x2* o8 = (u32x2*)(H + (size_t)(row0 + r) * DM) + lane;
#pragma unroll
      for (int j = 0; j < 4; ++j) { const f32x4 y = v[j] * rs * av[j] + bv[j]; u32x2 w; w.x = cvt_pk_bf16(y[0], y[1]); w.y = cvt_pk_bf16(y[2], y[3]); o8[64 * j] = w; }
    }
  }
}
__device__ __forceinline__ void final_norm_phase(const Frame& F, float* __restrict__ x, const float* __restrict__ g) {
  const int gw = F.vcu * NWAVES + F.wave, NGW = F.G * NWAVES, lane = fresh_lane();
  f32x4 gv[4];
#pragma unroll
  for (int j = 0; j < 4; ++j) gv[j] = *(const f32x4*)(g + 4 * lane + 256 * j);
  for (int row = gw; row < MTOK; row += NGW) {
    f32x4* xr = (f32x4*)(x + (size_t)row * DM) + lane; f32x4 v[4]; float s = 0.f;
#pragma unroll
    for (int j = 0; j < 4; ++j) { v[j] = xr[64 * j]; s += (v[j][0] * v[j][0] + v[j][1] * v[j][1]) + (v[j][2] * v[j][2] + v[j][3] * v[j][3]); }
    const float rs = rsqrtf(wave_sum(s) * (1.0f / DM) + NORM_EPS);
#pragma unroll
    for (int j = 0; j < 4; ++j) xr[64 * j] = v[j] * rs * gv[j];
  }
}

constexpr int NPHASE = 14;
__global__ void __launch_bounds__(NWAVES * 64, 2) mk_fwd(Args args) {
  extern __shared__ __attribute__((aligned(16))) unsigned char lds_raw[];
  Frame F;
  F.lds = (LAS unsigned char*)lds_raw; F.wave = __builtin_amdgcn_readfirstlane(threadIdx.x >> 6);
  F.G = gridDim.x; { const int bx = blockIdx.x; F.vcu = (F.G % 8 == 0) ? (bx % 8) * (F.G / 8) + bx / 8 : bx; }
  F.in = args.in; F.out = args.out; F.ws = args.ws;
  unsigned char* ws = args.ws;
  for (int u = threadIdx.x; u < (LDS_BYTES - LDSCTL_OFF) / 4; u += NWAVES * 64) ((LAS unsigned*)(F.lds + LDSCTL_OFF))[u] = 0u;
  __syncthreads();
#if MK_SINGLE
  XcdBarrier bar = xcd_barrier_post((unsigned*)(ws + WS_CTL) + CW_BAR, (volatile LAS unsigned*)(F.lds + MISC_OFF) + 8);
#define GRID_BAR() xcd_barrier(bar)
#else
#define GRID_BAR() do {} while (0)
#endif
  const int lo = args.ph_lo, hi = args.ph_hi;
#ifndef PH_MASK
#define PH_MASK 0xFFFF
#endif
#define IN(k) (((PH_MASK >> (k)) & 1) && lo <= (k) && (k) < hi)
#define SEAM(k) do { if (IN(k) && IN((k) + 1)) GRID_BAR(); } while (0)
  const float* mod = (const float*)(ws + OFF_MOD);
  float* rsq_q = (float*)(ws + OFF_RSQQ); float* rsq_kv = (float*)(ws + OFF_RSQKV);
  const float* rope = (const float*)(ws + WS_ROPE);
  bf16_t* H = (bf16_t*)(ws + WS_H); bf16_t* ACT = (bf16_t*)(ws + WS_BIG);
  bf16_t* Vb = (bf16_t*)(ws + WS_V); bf16_t* Yb = (bf16_t*)(ws + WS_Y); bf16_t* Fb = (bf16_t*)(ws + WS_F); bf16_t* ZL = (bf16_t*)(ws + WS_ZL); bf16_t* Ob = (bf16_t*)(ws + WS_O);
  bf16_t* Qb = (bf16_t*)(ws + WS_H); bf16_t* KVb = (bf16_t*)(ws + WS_KV); bf16_t* KRb = (bf16_t*)(ws + WS_KR); bf16_t* GT = (bf16_t*)(ws + WS_GATES); bf16_t* YM = (bf16_t*)(ws + WS_H);
  const int cu = (int)blockIdx.x;

  if (IN(0)) { p0_prologue(F); } SEAM(0);
  if (IN(1)) { norm_mod_phase(F, F.in[0], F.in[5], mod + 0 * DM, mod + 1 * DM, H); } SEAM(1);
  if (IN(2)) { pg8::Gemm g{H, (const bf16_t*)(ws + WS_WGU1), MTOK, 2 * DFF, DM, DM, DM}; pg8::StaticOrder S; S.init(MTOK, 2 * DFF, F.G, cu);
    pg8::EpiSwiglu E{ACT}; pg8::gemm_phase(F.lds, g, S, E, F.wave); } SEAM(2);
  if (IN(3)) { pg8::Gemm g{ACT, (const bf16_t*)(ws + WS_WD1), MTOK, DM, DFF, DFF, DFF}; pg8::StaticOrder S; S.init(MTOK, DM, F.G, cu);
    pg8::EpiResid E{F.in[0], F.out, mod + 2 * DM, 0.5f}; pg8::gemm_phase(F.lds, g, S, E, F.wave); } SEAM(3);
  if (IN(4)) { norm_mod_phase(F, F.out, F.in[9], mod + 3 * DM, mod + 4 * DM, H); } SEAM(4);
  if (IN(5)) { pg8::Gemm g{H, (const bf16_t*)(ws + WS_WIN), MTOK, NWIN, DM, DM, DM}; pg8::StaticOrder S; S.init(MTOK, NWIN, F.G, cu);
    pg8::EpiWin E{Vb, GT, ZL, KRb, rsq_q, rsq_kv, rope}; pg8::gemm_phase(F.lds, g, S, E, F.wave); } SEAM(5);
#ifndef P6_PART
#define P6_PART 7
#endif
  if (IN(6)) {
    if (P6_PART & 1) { pg8::Gemm g{ZL, (const bf16_t*)(ws + WS_WQ), MTOK, NQ, QLR, ZLW, QLR}; pg8::StaticOrder S; S.init(MTOK, NQ, F.G, cu);
      pg8::EpiQ E{Qb, rsq_q, rope}; pg8::gemm_phase(F.lds, g, S, E, F.wave); }
    if (P6_PART & 2) { pg8::Gemm g{ZL + QLR, (const bf16_t*)(ws + WS_WKV), MTOK, NKV, KVLR, ZLW, KVLR}; pg8::StaticOrder S; S.init(MTOK, NKV, F.G, F.G - 1 - cu);
      pg8::EpiKV E{KVb, rsq_kv}; pg8::gemm_phase(F.lds, g, S, E, F.wave); }
    if (P6_PART & 4) fft::stage1(Vb, Yb, (const bf16_t*)(ws + WS_C64), (const float*)(ws + WS_TW), F.lds, F.vcu, F.G, F.wave);
  } SEAM(6);
  if (IN(7)) {
    fft::stage2(Yb, Fb, (const bf16_t*)(ws + WS_C128), F.lds, F.vcu, F.G, F.wave);
    { const int xl = F.vcu >> 5, qb = F.vcu & 31;
      for (int i = 0; i < 4; ++i) { const int bh = xl + 8 * i; if (F.G == 256) attn::attn_unit(bh >> 3, bh & 7, qb, Qb, KVb, KRb, Ob, F.lds, F.wave); }
      if (F.G != 256) for (int uu = cu; uu < 1024; uu += F.G) attn::attn_unit(uu >> 8, (uu >> 5) & 7, uu & 31, Qb, KVb, KRb, Ob, F.lds, F.wave); }
  } SEAM(7);
#ifndef MERGE_PART
#define MERGE_PART 3
#endif
  if (IN(8)) {
#ifndef DBG_SRC
#define DBG_SRC 0
#endif
    if (MERGE_PART & 1) { pg8::Gemm g{DBG_SRC == 1 ? Vb : DBG_SRC == 2 ? Yb : Fb, (const bf16_t*)(ws + WS_WF), MTOK, DM, 512, DBG_SRC ? 1024 : 512, 512}; pg8::StaticOrder S; S.init(MTOK, DM, F.G, cu);
      pg8::EpiMerge<false, 0> E{YM, GT}; pg8::gemm_phase(F.lds, g, S, E, F.wave); }
    if (MERGE_PART == 3) { pg8::Gemm g{Ob, (const bf16_t*)(ws + WS_WM), MTOK, DM, 512, 512, 512}; pg8::StaticOrder S; S.init(MTOK, DM, F.G, cu);
      pg8::EpiMerge<true, 1024> E{YM, GT}; pg8::gemm_phase(F.lds, g, S, E, F.wave); }
    if (MERGE_PART == 2) { pg8::Gemm g{Ob, (const bf16_t*)(ws + WS_WM), MTOK, DM, 512, 512, 512}; pg8::StaticOrder S; S.init(MTOK, DM, F.G, cu);
      pg8::EpiMerge<false, 1024> E{YM, GT}; pg8::gemm_phase(F.lds, g, S, E, F.wave); }
  } SEAM(8);
  if (IN(9)) { pg8::Gemm g{YM, (const bf16_t*)(ws + WS_WO), MTOK, DM, DM, DM, DM}; pg8::StaticOrder S; S.init(MTOK, DM, F.G, cu);
    pg8::EpiResid E{F.out, F.out, mod + 5 * DM, 1.0f}; pg8::gemm_phase(F.lds, g, S, E, F.wave); } SEAM(9);
  if (IN(10)) { norm_mod_phase(F, F.out, F.in[18], mod + 6 * DM, mod + 7 * DM, H); } SEAM(10);
  if (IN(11)) { pg8::Gemm g{H, (const bf16_t*)(ws + WS_WGU2), MTOK, 2 * DFF, DM, DM, DM}; pg8::StaticOrder S; S.init(MTOK, 2 * DFF, F.G, cu);
    pg8::EpiSwiglu E{ACT}; pg8::gemm_phase(F.lds, g, S, E, F.wave); } SEAM(11);
  if (IN(12)) { pg8::Gemm g{ACT, (const bf16_t*)(ws + WS_WD2), MTOK, DM, DFF, DFF, DFF}; pg8::StaticOrder S; S.init(MTOK, DM, F.G, cu);
    pg8::EpiResid E{F.out, F.out, mod + 8 * DM, 0.5f}; pg8::gemm_phase(F.lds, g, S, E, F.wave); } SEAM(12);
  if (IN(13)) { final_norm_phase(F, F.out, F.in[22]); }
#undef IN
#undef SEAM
}

extern "C" void kernel_launch(void* const* d_in, const int* in_sizes, int n_in, void* d_out, int out_size, void* d_ws, size_t ws_size, hipStream_t stream) {
  static int grid = 0;
  if (grid == 0) {
    if (n_in != 23 || in_sizes[0] != MTOK * DM || out_size != MTOK * DM || ws_size < WS_END) {
      fprintf(stderr, "kernel_launch: unexpected shapes n_in %d in0 %d out %d ws %zu (need >= %zu)\n", n_in, n_in > 0 ? in_sizes[0] : -1, out_size, ws_size, (size_t)WS_END); grid = -1; return; }
    int dev = 0, cus = 0;
    if (hipGetDevice(&dev) != hipSuccess || hipDeviceGetAttribute(&cus, hipDeviceAttributeMultiprocessorCount, dev) != hipSuccess) { grid = -1; return; }
    if (hipFuncSetAttribute((const void*)mk_fwd, hipFuncAttributeMaxDynamicSharedMemorySize, LDS_BYTES) != hipSuccess) { fprintf(stderr, "kernel_launch: hipFuncSetAttribute failed\n"); grid = -1; return; }
    grid = cus;
  }
  if (grid < 0) return;
  (void)hipMemsetAsync((char*)d_ws + WS_CTL, 0, CTL_ZERO_BYTES, stream);
  Args a{};
  for (int i = 0; i < 23; ++i) a.in[i] = (const float*)d_in[i];
  a.out = (float*)d_out; a.ws = (unsigned char*)d_ws;
#if MK_SINGLE
  a.ph_lo = 0; a.ph_hi = NPHASE;
  hipLaunchKernelGGL(mk_fwd, dim3(grid), dim3(NWAVES * 64), LDS_BYTES, stream, a);
#else
  for (int p = 0; p < NPHASE; ++p) { a.ph_lo = p; a.ph_hi = p + 1; hipLaunchKernelGGL(mk_fwd, dim3(grid), dim3(NWAVES * 64), LDS_BYTES, stream, a); }
#endif
}
```

```cpp
#include <hip/hip_runtime.h>
#include <cstdio>
#include <cstdint>

#define LAS __attribute__((address_space(3)))
#define GAS __attribute__((address_space(1)))
typedef unsigned short bf16_t;
typedef short bf16x8 __attribute__((ext_vector_type(8)));
typedef short s16x4 __attribute__((ext_vector_type(4)));
typedef float f32x4 __attribute__((ext_vector_type(4)));
typedef float f32x2 __attribute__((ext_vector_type(2)));
typedef float f32x16 __attribute__((ext_vector_type(16)));
typedef unsigned u32x4 __attribute__((ext_vector_type(4)));
typedef unsigned u32x2 __attribute__((ext_vector_type(2)));

#ifndef MK_SINGLE
#define MK_SINGLE 1
#endif

constexpr int BATCH = 4, SEQ = 8192, DM = 1024, MTOK = BATCH * SEQ, DFF = 2816, NADA = 9 * DM;
constexpr int NWIN = 3840;
constexpr int QLR = 384, KVLR = 256, NQ = 768, NKV = 1024, ZLW = 768;
constexpr float NORM_EPS = 1e-6f;
constexpr float SCQ = 0.10206207261596575f * 1.4426950408889634f;

constexpr size_t MiB = 1u << 20;
constexpr size_t WS_CTL = 0, CTL_ZERO_BYTES = 2 * MiB;
constexpr size_t OFF_MOD = 256 * 1024, OFF_RSQQ = 512 * 1024, OFF_RSQKV = 640 * 1024;
constexpr size_t WS_ROPE = 2 * MiB;
constexpr size_t WS_TW = 6 * MiB;
constexpr size_t WS_C64 = 6 * MiB + 64 * 1024, WS_S64 = WS_C64 + 8192, WS_NS64 = WS_S64 + 8192;
constexpr size_t WS_C128 = 6 * MiB + 128 * 1024, WS_S128 = WS_C128 + 32768;
constexpr size_t WS_WGU1 = 8 * MiB, WS_WD1 = 19 * MiB, WS_WGU2 = 25 * MiB, WS_WD2 = 36 * MiB, WS_WIN = 42 * MiB;
constexpr size_t WS_WQ = 50 * MiB, WS_WKV = 51 * MiB, WS_WF = 52 * MiB, WS_WM = 53 * MiB, WS_WO = 54 * MiB;
constexpr size_t WS_H = 64 * MiB;
constexpr size_t WS_KV = 128 * MiB;
constexpr size_t WS_GATES = 192 * MiB;
constexpr size_t WS_KR = 320 * MiB;
constexpr size_t WS_BIG = 322 * MiB;
constexpr size_t WS_V = WS_BIG, WS_F = WS_BIG, WS_Y = WS_BIG + 64 * MiB, WS_ZL = WS_BIG + 128 * MiB, WS_O = WS_ZL;
constexpr size_t WS_END = 498 * MiB;
constexpr int CW_BAR = 4096;

typedef __bf16 bf16x2_t __attribute__((ext_vector_type(2)));
__device__ __forceinline__ unsigned cvt_pk_bf16(float lo, float hi) { f32x2 v = {lo, hi}; bf16x2_t b = __builtin_convertvector(v, bf16x2_t); return __builtin_bit_cast(unsigned, b); }
__device__ __forceinline__ float bf_lo(unsigned w) { return __uint_as_float(w << 16); }
__device__ __forceinline__ float bf_hi(unsigned w) { return __uint_as_float(w & 0xffff0000u); }
__device__ __forceinline__ u32x4 pack8(f32x4 a, f32x4 b) { u32x4 w; w.x = cvt_pk_bf16(a[0], a[1]); w.y = cvt_pk_bf16(a[2], a[3]); w.z = cvt_pk_bf16(b[0], b[1]); w.w = cvt_pk_bf16(b[2], b[3]); return w; }
__device__ __forceinline__ float fast_sigmoid(float v) { return __builtin_amdgcn_rcpf(1.0f + __builtin_amdgcn_exp2f(-1.4426950408889634f * v)); }
__device__ __forceinline__ float wave_sum(float v) {
#pragma unroll
  for (int o = 1; o < 64; o <<= 1) v += __shfl_xor(v, o);
  return v;
}
__device__ __forceinline__ int fresh_lane() { int l; asm volatile("v_mbcnt_lo_u32_b32 %0, -1, 0\n\tv_mbcnt_hi_u32_b32 %0, -1, %0" : "=v"(l)); return l; }
#define LDS_WAIT() asm volatile("s_waitcnt lgkmcnt(0)" ::: "memory")
#define VM_WAIT() asm volatile("s_waitcnt vmcnt(0)" ::: "memory")

namespace pg8 {
constexpr int BM = 256, BK = 64, HALF = 128, HTB = HALF * BK * 2, STAGE_BYTES = 8 * HTB, NXCD = 8, WGM = 8;
__host__ __device__ __forceinline__ int lds_byte(int r, int c) { const int st = (r >> 4) * 2 + (c >> 5), rr = r & 15, cc = c & 31, ob = rr * 64 + cc * 2; return st * 1024 + (ob ^ (((ob >> 9) & 1) << 5)); }
__host__ __device__ __forceinline__ void stage_rc(int b, int& R, int& C) { const int st = b / 1024, sb = b % 1024, swz = sb ^ (((sb >> 9) & 1) << 5); R = (st >> 1) * 16 + swz / 64; C = (st & 1) * 32 + (swz % 64) / 2; }
__host__ __device__ __forceinline__ int perm32(int rho) { const int n = rho >> 4, i = rho & 15; return 8 * (i >> 2) + 4 * n + (i & 3); }
struct Unit { int pm, pn; };
struct Gemm { const bf16_t* A; const bf16_t* Bt; int M, N, K, lda, ldb; };
struct StaticOrder {
  int nM, nN, nwg, G, c;
  __host__ __device__ void init(int M, int N, int G_, int c_) { nM = M / BM; nN = N / BM; nwg = nM * nN; G = G_; c = c_; }
  __host__ __device__ bool next(int i, Unit& u) const {
    const long L = (long)i * G + c; if (L >= nwg) return false;
    int wgid = (int)L; { const int q = nwg / NXCD, r = nwg % NXCD, xcd = wgid % NXCD, off = wgid / NXCD; wgid = (xcd < r ? xcd * (q + 1) : r * (q + 1) + (xcd - r) * q) + off; }
    const int nig = WGM * nN, gid = wgid / nig, fm = gid * WGM, gsz = (nM - fm) < WGM ? (nM - fm) : WGM;
    u.pm = fm + ((wgid % nig) % gsz); u.pn = (wgid % nig) / gsz; return true;
  }
};
template <class Epi, class Sched, bool ALIGN_EPI = true, bool SP2 = true>
__device__ __forceinline__ void gemm_phase(LAS unsigned char* lds, const Gemm g, const Sched& S, const Epi& E, const int wid) {
  const int lane0 = fresh_lane();
  const int tid = wid * 64 + lane0, wr = wid >> 2, wc = wid & 3, fr = lane0 & 15, fq = lane0 >> 4;
  const int K = g.K, nt = K / BK;
  unsigned voffA[2], voffB[2];
#pragma unroll
  for (int i = 0; i < 2; ++i) { int R, C; stage_rc(tid * 16 + i * 8192, R, C); const int Rb = Epi::PERM ? ((R & ~31) + perm32(R & 31)) : R;
    voffA[i] = (unsigned)(R * g.lda + C) * 2u; voffB[i] = (unsigned)(Rb * g.ldb + C) * 2u; }
  const size_t kstep = (size_t)(BK * 2);
  const size_t hstepA = (size_t)HALF * g.lda * 2, hstepB = (size_t)HALF * g.ldb * 2;
  const size_t tstepA = 2 * hstepA, tstepB = 2 * hstepB;
  const unsigned ldsw = (unsigned)wid * 1024u;
  const int aoff = lds_byte(wr * 64 + fr, fq * 8), boff = lds_byte(wc * 32 + fr, fq * 8);
#define PG8_SA(b, h) (((b) * 2 + (h)) * HTB)
#define PG8_SB(b, h) ((4 + (b) * 2 + (h)) * HTB)
#define PG8_STAGE(bufoff, gbase, voff) do { _Pragma("unroll") for (int _i = 0; _i < 2; ++_i) \
    __builtin_amdgcn_global_load_lds((const unsigned*)((const char*)(gbase) + (voff)[_i]), (LAS unsigned*)(lds + (bufoff) + ldsw + _i * 8192), 16, 0, 0); } while (0)
#define PG8_LDA(dst, b, h) do { _Pragma("unroll") for (int m = 0; m < 4; ++m) _Pragma("unroll") for (int k = 0; k < 2; ++k) dst[m][k] = *(const LAS bf16x8*)(lds + PG8_SA(b, h) + aoff + m * 2048 + k * 1024); } while (0)
#define PG8_LDB(dst, b, h) do { _Pragma("unroll") for (int n = 0; n < 2; ++n) _Pragma("unroll") for (int k = 0; k < 2; ++k) dst[n][k] = *(const LAS bf16x8*)(lds + PG8_SB(b, h) + boff + n * 2048 + k * 1024); } while (0)
#define PG8_MMA(ai, bj, At, Bt) do { __builtin_amdgcn_s_setprio(1); _Pragma("unroll") for (int m = 0; m < 4; ++m) _Pragma("unroll") for (int n = 0; n < 2; ++n) _Pragma("unroll") for (int k = 0; k < 2; ++k) \
    acc[ai][bj][m][n] = __builtin_amdgcn_mfma_f32_16x16x32_bf16(Bt[n][k], At[m][k], acc[ai][bj][m][n], 0, 0, 0); __builtin_amdgcn_s_setprio(0); } while (0)
#define PG8_WAIT_V(n) asm volatile("s_waitcnt vmcnt(" #n ")" ::: "memory")
#define PG8_WAIT_L(n) asm volatile("s_waitcnt lgkmcnt(" #n ")" ::: "memory")
#define PG8_BAR __builtin_amdgcn_s_barrier()
#define PG8_SCHED __builtin_amdgcn_sched_barrier(0)
  Unit cur, nxt; int ui = 0;
  if (!S.next(0, cur)) return;
  f32x4 acc[2][2][4][2];
#pragma unroll
  for (int a = 0; a < 2; ++a)
#pragma unroll
    for (int b = 0; b < 2; ++b)
#pragma unroll
      for (int m = 0; m < 4; ++m)
#pragma unroll
        for (int n = 0; n < 2; ++n) acc[a][b][m][n] = (f32x4){0.f, 0.f, 0.f, 0.f};
  bf16x8 At[4][2], B0[2][2], B1[2][2];
  const char* cA = (const char*)g.A + (size_t)cur.pm * tstepA; const char* cB = (const char*)g.Bt + (size_t)cur.pn * tstepB;
  if constexpr (SP2) {
    PG8_STAGE(PG8_SB(0, 0), cB, voffB); PG8_STAGE(PG8_SB(0, 1), cB + hstepB, voffB); PG8_STAGE(PG8_SA(0, 0), cA, voffA); PG8_STAGE(PG8_SA(0, 1), cA + hstepA, voffA);
    if (wr == 1) PG8_BAR;
    PG8_WAIT_V(2); PG8_BAR;
    PG8_STAGE(PG8_SB(1, 0), cB + kstep, voffB); PG8_STAGE(PG8_SA(1, 0), cA + kstep, voffA); PG8_STAGE(PG8_SB(1, 1), cB + hstepB + kstep, voffB);
    PG8_WAIT_V(6); PG8_BAR;
  } else {
    PG8_STAGE(PG8_SB(0, 0), cB, voffB); PG8_STAGE(PG8_SA(0, 0), cA, voffA); PG8_STAGE(PG8_SB(0, 1), cB + hstepB, voffB); PG8_STAGE(PG8_SA(0, 1), cA + hstepA, voffA);
    if (wr == 1) PG8_BAR;
    PG8_WAIT_V(4); PG8_BAR;
    PG8_STAGE(PG8_SB(1, 0), cB + kstep, voffB); PG8_STAGE(PG8_SA(1, 0), cA + kstep, voffA); PG8_STAGE(PG8_SB(1, 1), cB + hstepB + kstep, voffB);
    PG8_WAIT_V(6); PG8_BAR;
  }
  for (;;) {
    const bool has_next = S.next(ui + 1, nxt);
    const char* nA = has_next ? (const char*)g.A + (size_t)nxt.pm * tstepA : cA; const char* nB = has_next ? (const char*)g.Bt + (size_t)nxt.pn * tstepB : cB;
    for (int t = 0; t < nt; t += 2) {
      const bool last = (t == nt - 2);
      const char* a1 = cA + (size_t)(t + 1) * kstep;
      const char* a2 = last ? nA : cA + (size_t)(t + 2) * kstep; const char* b2 = last ? nB : cB + (size_t)(t + 2) * kstep;
      const char* a3 = a2 + kstep; const char* b3 = b2 + kstep;
      if constexpr (SP2) {
        PG8_LDB(B0, 0, 0); PG8_LDB(B1, 0, 1); PG8_SCHED; PG8_LDA(At, 0, 0); PG8_STAGE(PG8_SA(1, 1), a1 + hstepA, voffA);
        PG8_WAIT_V(8); PG8_WAIT_L(0); PG8_BAR; PG8_MMA(0, 0, At, B0); PG8_MMA(0, 1, At, B1); PG8_BAR; PG8_SCHED;
        PG8_LDA(At, 0, 1); PG8_STAGE(PG8_SB(0, 0), b2, voffB); PG8_STAGE(PG8_SB(0, 1), b2 + hstepB, voffB); PG8_STAGE(PG8_SA(0, 0), a2, voffA);
        PG8_WAIT_V(8); PG8_WAIT_L(0); PG8_BAR; PG8_MMA(1, 0, At, B0); PG8_MMA(1, 1, At, B1); PG8_BAR; PG8_SCHED;
        PG8_LDB(B0, 1, 0); PG8_LDB(B1, 1, 1); PG8_SCHED; PG8_LDA(At, 1, 0); PG8_STAGE(PG8_SA(0, 1), a2 + hstepA, voffA);
        PG8_WAIT_V(8); PG8_WAIT_L(0); PG8_BAR; PG8_MMA(0, 0, At, B0); PG8_MMA(0, 1, At, B1); PG8_BAR; PG8_SCHED;
        PG8_LDA(At, 1, 1); PG8_STAGE(PG8_SB(1, 0), b3, voffB); PG8_STAGE(PG8_SB(1, 1), b3 + hstepB, voffB); PG8_STAGE(PG8_SA(1, 0), a3, voffA);
        PG8_WAIT_V(8); PG8_WAIT_L(0); PG8_BAR; PG8_MMA(1, 0, At, B0); PG8_MMA(1, 1, At, B1); PG8_BAR; PG8_SCHED;
      } else {
        PG8_LDB(B0, 0, 0); PG8_SCHED; PG8_LDA(At, 0, 0); PG8_STAGE(PG8_SA(1, 1), a1 + hstepA, voffA);
        PG8_WAIT_L(8); PG8_BAR; PG8_WAIT_L(0); PG8_MMA(0, 0, At, B0); PG8_BAR; PG8_SCHED;
        PG8_LDB(B1, 0, 1); PG8_STAGE(PG8_SB(0, 0), b2, voffB);
        PG8_BAR; PG8_WAIT_L(0); PG8_MMA(0, 1, At, B1); PG8_BAR;
        PG8_LDA(At, 0, 1); PG8_STAGE(PG8_SA(0, 0), a2, voffA);
        PG8_BAR; PG8_WAIT_L(0); PG8_MMA(1, 0, At, B0); PG8_BAR; PG8_SCHED;
        PG8_STAGE(PG8_SB(0, 1), b2 + hstepB, voffB);
        PG8_WAIT_V(6); PG8_BAR; PG8_MMA(1, 1, At, B1); PG8_BAR;
        PG8_LDB(B0, 1, 0); PG8_SCHED; PG8_LDA(At, 1, 0); PG8_STAGE(PG8_SA(0, 1), a2 + hstepA, voffA);
        PG8_WAIT_L(8); PG8_BAR; PG8_WAIT_L(0); PG8_MMA(0, 0, At, B0); PG8_BAR; PG8_SCHED;
        PG8_LDB(B1, 1, 1); PG8_STAGE(PG8_SB(1, 0), b3, voffB);
        PG8_BAR; PG8_WAIT_L(0); PG8_MMA(0, 1, At, B1); PG8_BAR;
        PG8_LDA(At, 1, 1); PG8_STAGE(PG8_SA(1, 0), a3, voffA);
        PG8_BAR; PG8_WAIT_L(0); PG8_MMA(1, 0, At, B0); PG8_BAR; PG8_SCHED;
        PG8_STAGE(PG8_SB(1, 1), b3 + hstepB, voffB);
        PG8_WAIT_V(6); PG8_BAR; PG8_MMA(1, 1, At, B1); PG8_BAR;
      }
    }
    if constexpr (ALIGN_EPI) { if (wr == 0) PG8_BAR; }
    { const int le = fresh_lane(); E(acc, cur, wr, wc, le & 15, le >> 4); }
    if (!has_next) break;
#pragma unroll
    for (int a = 0; a < 2; ++a)
#pragma unroll
      for (int b = 0; b < 2; ++b)
#pragma unroll
        for (int m = 0; m < 4; ++m)
#pragma unroll
          for (int n = 0; n < 2; ++n) acc[a][b][m][n] = (f32x4){0.f, 0.f, 0.f, 0.f};
    cur = nxt; cA = nA; cB = nB; ++ui;
    if constexpr (ALIGN_EPI) { if (wr == 1) PG8_BAR; }
  }
  PG8_WAIT_V(0);
  if constexpr (!ALIGN_EPI) { if (wr == 0) PG8_BAR; }
  PG8_BAR;
#undef PG8_SA
#undef PG8_SB
#undef PG8_STAGE
#undef PG8_LDA
#undef PG8_LDB
#undef PG8_MMA
#undef PG8_WAIT_V
#undef PG8_WAIT_L
#undef PG8_BAR
#undef PG8_SCHED
}

typedef f32x4 Acc[2][2][4][2];
struct EpiSwiglu { static constexpr bool PERM = true; bf16_t* O;
  __device__ __forceinline__ void operator()(const Acc& acc, const Unit& u, int wr, int wc, int fr, int fq) const {
    const int row0 = u.pm * BM + wr * 64 + fr, col0 = u.pn * 128 + wc * 32 + 8 * fq;
#pragma unroll
    for (int ai = 0; ai < 2; ++ai)
#pragma unroll
      for (int m = 0; m < 4; ++m) { bf16_t* p = O + (size_t)(row0 + ai * HALF + m * 16) * DFF + col0; f32x4 r[2];
#pragma unroll
        for (int n = 0; n < 2; ++n)
#pragma unroll
          for (int j = 0; j < 4; ++j) { const float gv = acc[ai][0][m][n][j], uv = acc[ai][1][m][n][j]; r[n][j] = gv * fast_sigmoid(gv) * uv; }
        *(u32x4*)p = pack8(r[0], r[1]); }
  }
};
struct EpiResid { static constexpr bool PERM = false; const float* base; float* out; const float* gvec; float coef;
  __device__ __forceinline__ void operator()(const Acc& acc, const Unit& u, int wr, int wc, int fr, int fq) const {
    const int row0 = u.pm * BM + wr * 64 + fr, col0 = u.pn * BM + wc * 32 + 4 * fq; const float* g = gvec + (size_t)(u.pm >> 5) * NADA;
    f32x4 gv[2][2];
#pragma unroll
    for (int bj = 0; bj < 2; ++bj)
#pragma unroll
      for (int n = 0; n < 2; ++n) gv[bj][n] = *(const f32x4*)(g + col0 + bj * HALF + n * 16) * coef;
#pragma unroll
    for (int ai = 0; ai < 2; ++ai)
#pragma unroll
      for (int m = 0; m < 4; ++m) { const size_t off = (size_t)(row0 + ai * HALF + m * 16) * DM + col0;
#pragma unroll
        for (int bj = 0; bj < 2; ++bj)
#pragma unroll
          for (int n = 0; n < 2; ++n) { const f32x4 b = *(const f32x4*)(base + off + bj * HALF + n * 16); *(f32x4*)(out + off + bj * HALF + n * 16) = b + gv[bj][n] * acc[ai][bj][m][n]; } }
  }
};
struct EpiWin { static constexpr bool PERM = true; bf16_t *V, *GATES, *ZL, *KR; float *rsq_q, *rsq_kv; const float* rope;
  __device__ __forceinline__ void operator()(const Acc& acc, const Unit& u, int wr, int wc, int fr, int fq) const {
    const int row0 = u.pm * BM + wr * 64 + fr, cw = wc * 32 + 8 * fq;
    if (u.pn < 4) {
#pragma unroll
      for (int ai = 0; ai < 2; ++ai)
#pragma unroll
        for (int m = 0; m < 4; ++m)
#pragma unroll
          for (int bj = 0; bj < 2; ++bj) *(u32x4*)(V + (size_t)(row0 + ai * HALF + m * 16) * 1024 + u.pn * 256 + bj * HALF + cw) = pack8(acc[ai][bj][m][0], acc[ai][bj][m][1]);
    } else if (u.pn < 12) {
#pragma unroll
      for (int ai = 0; ai < 2; ++ai)
#pragma unroll
        for (int m = 0; m < 4; ++m)
#pragma unroll
          for (int bj = 0; bj < 2; ++bj) { f32x4 a = acc[ai][bj][m][0], b = acc[ai][bj][m][1];
#pragma unroll
            for (int j = 0; j < 4; ++j) { a[j] = fast_sigmoid(a[j]); b[j] = fast_sigmoid(b[j]); }
            *(u32x4*)(GATES + (size_t)(row0 + ai * HALF + m * 16) * 2048 + (u.pn - 4) * 256 + bj * HALF + cw) = pack8(a, b); }
    } else {
#pragma unroll
      for (int bj = 0; bj < 2; ++bj) { const int zc0 = (u.pn - 12) * 256 + bj * HALF;
        if (zc0 < 640) { float* rsq = zc0 < 384 ? rsq_q : rsq_kv;
#pragma unroll
          for (int ai = 0; ai < 2; ++ai)
#pragma unroll
            for (int m = 0; m < 4; ++m) { const int row = row0 + ai * HALF + m * 16; const f32x4 a = acc[ai][bj][m][0], b = acc[ai][bj][m][1];
              *(u32x4*)(ZL + (size_t)row * ZLW + zc0 + cw) = pack8(a, b);
              float ss = (a[0] * a[0] + a[1] * a[1]) + (a[2] * a[2] + a[3] * a[3]) + (b[0] * b[0] + b[1] * b[1]) + (b[2] * b[2] + b[3] * b[3]);
              ss += __shfl_xor(ss, 16); ss += __shfl_xor(ss, 32);
              if (fq == 0) __hip_atomic_fetch_add(rsq + row, ss, __ATOMIC_RELAXED, __HIP_MEMORY_SCOPE_AGENT); }
        } else if (wc == 0) {
#pragma unroll
          for (int ai = 0; ai < 2; ++ai)
#pragma unroll
            for (int m = 0; m < 4; ++m) { const int row = row0 + ai * HALF + m * 16; const f32x4 a = acc[ai][bj][m][0], b = acc[ai][bj][m][1];
              const f32x4 cs = *(const f32x4*)(rope + (size_t)row * 32 + 4 * fq), sn = *(const f32x4*)(rope + (size_t)row * 32 + 16 + 4 * fq);
              f32x4 oa, ob;
              oa[0] = a[0] * cs[0] - a[1] * sn[0]; oa[1] = a[1] * cs[0] + a[0] * sn[0]; oa[2] = a[2] * cs[1] - a[3] * sn[1]; oa[3] = a[3] * cs[1] + a[2] * sn[1];
              ob[0] = b[0] * cs[2] - b[1] * sn[2]; ob[1] = b[1] * cs[2] + b[0] * sn[2]; ob[2] = b[2] * cs[3] - b[3] * sn[3]; ob[3] = b[3] * cs[3] + b[2] * sn[3];
              *(u32x4*)(KR + (size_t)row * 32 + 8 * fq) = pack8(oa, ob); }
        }
      }
    }
  }
};
struct EpiQ { static constexpr bool PERM = true; bf16_t* Q; const float* rsq; const float* rope;
  __device__ __forceinline__ void operator()(const Acc& acc, const Unit& u, int wr, int wc, int fr, int fq) const {
    const int row0 = u.pm * BM + wr * 64 + fr;
#pragma unroll
    for (int ai = 0; ai < 2; ++ai)
#pragma unroll
      for (int m = 0; m < 4; ++m) { const unsigned row = (unsigned)(row0 + ai * HALF + m * 16); const float rs = rsqrtf(rsq[row] * (1.0f / QLR) + NORM_EPS);
#pragma unroll
        for (int bj = 0; bj < 2; ++bj) { const unsigned c0 = (unsigned)(u.pn * BM + bj * HALF + wc * 32 + 8 * fq), d = c0 % 96u;
          f32x4 a = acc[ai][bj][m][0] * rs, b = acc[ai][bj][m][1] * rs;
          if (d >= 64u) { const unsigned j0 = (d - 64u) >> 1; const f32x4 cs = *(const f32x4*)(rope + (row * 32u + j0)), sn = *(const f32x4*)(rope + (row * 32u + 16u + j0));
            f32x4 oa, ob;
            oa[0] = a[0] * cs[0] - a[1] * sn[0]; oa[1] = a[1] * cs[0] + a[0] * sn[0]; oa[2] = a[2] * cs[1] - a[3] * sn[1]; oa[3] = a[3] * cs[1] + a[2] * sn[1];
            ob[0] = b[0] * cs[2] - b[1] * sn[2]; ob[1] = b[1] * cs[2] + b[0] * sn[2]; ob[2] = b[2] * cs[3] - b[3] * sn[3]; ob[3] = b[3] * cs[3] + b[2] * sn[3];
            a = oa; b = ob; }
          *(u32x4*)(Q + (row * (unsigned)NQ + c0)) = pack8(a, b);
          asm volatile("" ::: "memory"); } }
  }
};
struct EpiKV { static constexpr bool PERM = true; bf16_t* KV; const float* rsq;
  __device__ __forceinline__ void operator()(const Acc& acc, const Unit& u, int wr, int wc, int fr, int fq) const {
    const int row0 = u.pm * BM + wr * 64 + fr;
#pragma unroll
    for (int ai = 0; ai < 2; ++ai)
#pragma unroll
      for (int m = 0; m < 4; ++m) { const int row = row0 + ai * HALF + m * 16; const float rs = rsqrtf(rsq[row] * (1.0f / KVLR) + NORM_EPS);
#pragma unroll
        for (int bj = 0; bj < 2; ++bj) { const int c0 = u.pn * BM + bj * HALF + wc * 32 + 8 * fq;
          *(u32x4*)(KV + (size_t)row * NKV + c0) = pack8(acc[ai][bj][m][0] * rs, acc[ai][bj][m][1] * rs); } }
  }
};
template <bool ADD, int GOFF> struct EpiMerge { static constexpr bool PERM = true; bf16_t* YM; const bf16_t* G;
  __device__ __forceinline__ void operator()(const Acc& acc, const Unit& u, int wr, int wc, int fr, int fq) const {
    const int row0 = u.pm * BM + wr * 64 + fr;
#pragma unroll
    for (int ai = 0; ai < 2; ++ai)
#pragma unroll
      for (int m = 0; m < 4; ++m) { const int row = row0 + ai * HALF + m * 16;
#pragma unroll
        for (int bj = 0; bj < 2; ++bj) { const int c0 = u.pn * BM + bj * HALF + wc * 32 + 8 * fq;
          const u32x4 gw = *(const u32x4*)(G + (size_t)row * 2048 + GOFF + c0);
          f32x4 a = acc[ai][bj][m][0], b = acc[ai][bj][m][1];
#ifndef DBG_NOGATE
          a[0] *= bf_lo(gw.x); a[1] *= bf_hi(gw.x); a[2] *= bf_lo(gw.y); a[3] *= bf_hi(gw.y); b[0] *= bf_lo(gw.z); b[1] *= bf_hi(gw.z); b[2] *= bf_lo(gw.w); b[3] *= bf_hi(gw.w);
#else
          a[0] += 1e-30f * bf_lo(gw.x);
#endif
          bf16_t* p = YM + (size_t)row * DM + c0;
          if (ADD) { const u32x4 t = *(const u32x4*)p;
            a[0] += bf_lo(t.x); a[1] += bf_hi(t.x); a[2] += bf_lo(t.y); a[3] += bf_hi(t.y); b[0] += bf_lo(t.z); b[1] += bf_hi(t.z); b[2] += bf_lo(t.w); b[3] += bf_hi(t.w); }
          *(u32x4*)p = pack8(a, b); } }
  }
};
}

namespace attn {
constexpr int SHM_V = 64 * 64 * 2, SHM_K = 64 * 256, LDS_BYTES = 2 * SHM_V + 2 * SHM_K + 8 * 64 * 4;
constexpr float THRL = 11.5f;
#define KSWZ(row, colB) ((row) * 256 + ((colB) ^ (((row) & 7) << 4)))
__device__ __forceinline__ int crow(int r, int hi) { return (r & 3) + 8 * (r >> 2) + 4 * hi; }
typedef short v4i16_t __attribute__((ext_vector_type(4)));
__device__ __forceinline__ s16x4 vtr(const LAS unsigned char* p) { return __builtin_bit_cast(s16x4, __builtin_amdgcn_ds_read_tr16_b64_v4i16((LAS v4i16_t*)p)); }
__device__ __forceinline__ int swap23(int k) { return (k & ~0xC) | ((k & 4) << 1) | ((k & 8) >> 1); }
__device__ __forceinline__ int v_rd_base(int lane) { return ((lane & 3) << 3) | (((lane >> 2) & 3) << 6) | (((lane >> 4) & 1) << 5) | (((lane >> 5) & 1) << 8); }
template <int NB> __device__ __forceinline__ int t_st(int k, int n) { const int kk = swap23(k); return ((kk >> 3) * NB + (n >> 5)) * 512 + ((kk & 7) * 32 + (n & 31)) * 2; }
template <int NB> __device__ __forceinline__ bf16x8 t_frag(const LAS unsigned char* base, int ks, int nb) {
  const s16x4 l = vtr(base + nb * 512 + ks * (1024 * NB)), h = vtr(base + nb * 512 + ks * (1024 * NB) + 512 * NB);
  return (bf16x8){l[0], l[1], l[2], l[3], h[0], h[1], h[2], h[3]};
}
__device__ __forceinline__ void partialSM(f32x16& p0, f32x16& p1, float& m_reg, float& mn, float& alpha) {
  float pmax = p0[0];
#pragma unroll
  for (int r = 1; r < 16; ++r) pmax = fmaxf(pmax, p0[r]);
#pragma unroll
  for (int r = 0; r < 16; ++r) pmax = fmaxf(pmax, p1[r]);
  { auto rr = __builtin_amdgcn_permlane32_swap(__float_as_uint(pmax), __float_as_uint(pmax), false, false);
    pmax = fmaxf(__uint_as_float(rr[0]), __uint_as_float(rr[1])); }
  if (__builtin_expect(__all(pmax - m_reg <= THRL), 1)) { mn = m_reg; alpha = 1.f; }
  else { mn = fmaxf(m_reg, pmax); alpha = __builtin_amdgcn_exp2f(m_reg - mn); m_reg = mn; }
#pragma unroll
  for (int r = 0; r < 16; ++r) { p0[r] -= mn; p1[r] -= mn; }
#pragma unroll
  for (int r = 0; r < 16; ++r) p0[r] = __builtin_amdgcn_exp2f(p0[r]);
}
__device__ __forceinline__ void finishSM(f32x16& p0, f32x16& p1, float alpha, float& l_reg, bf16x8& pa0, bf16x8& pa1, bf16x8& pa2, bf16x8& pa3) {
#pragma unroll
  for (int r = 0; r < 16; ++r) p1[r] = __builtin_amdgcn_exp2f(p1[r]);
  float ps = 0;
#pragma unroll
  for (int r = 0; r < 16; ++r) ps += p0[r];
#pragma unroll
  for (int r = 0; r < 16; ++r) ps += p1[r];
  { auto rr = __builtin_amdgcn_permlane32_swap(__float_as_uint(ps), __float_as_uint(ps), false, false);
    ps = __uint_as_float(rr[0]) + __uint_as_float(rr[1]); }
  l_reg = l_reg * alpha + ps;
#define PK4(P, BASE, OUT) do { unsigned a0 = cvt_pk_bf16(P[BASE + 0], P[BASE + 1]), a1 = cvt_pk_bf16(P[BASE + 2], P[BASE + 3]);   \
    unsigned b0 = cvt_pk_bf16(P[BASE + 4], P[BASE + 5]), b1 = cvt_pk_bf16(P[BASE + 6], P[BASE + 7]);                              \
    auto r0 = __builtin_amdgcn_permlane32_swap(a0, b0, false, false); auto r1 = __builtin_amdgcn_permlane32_swap(a1, b1, false, false); \
    u32x4 w = {r0[0], r1[0], r0[1], r1[1]}; OUT = __builtin_bit_cast(bf16x8, w); } while (0)
  PK4(p0, 0, pa0); PK4(p0, 8, pa1); PK4(p1, 0, pa2); PK4(p1, 8, pa3);
#undef PK4
}
__device__ __forceinline__ void qkt(f32x16& p0, f32x16& p1, const LAS unsigned char* Ks, const bf16x8* qr, int r32, int hi) {
  p0 = f32x16{}; p1 = f32x16{};
#pragma unroll
  for (int d0 = 0; d0 < 6; ++d0) { const int cb = (d0 * 16 + hi * 8) * 2;
    const bf16x8 b0 = *(const LAS bf16x8*)(Ks + KSWZ(r32, cb));
    const bf16x8 b1 = *(const LAS bf16x8*)(Ks + KSWZ(32 + r32, cb));
    p0 = __builtin_amdgcn_mfma_f32_32x32x16_bf16(b0, qr[d0], p0, 0, 0, 0);
    p1 = __builtin_amdgcn_mfma_f32_32x32x16_bf16(b1, qr[d0], p1, 0, 0, 0); }
}
__device__ __forceinline__ void pv2(f32x16* o, const LAS unsigned char* vb, bf16x8 pa0, bf16x8 pa1, bf16x8 pa2, bf16x8 pa3) {
#pragma unroll
  for (int d0 = 0; d0 < 2; ++d0) {
    const bf16x8 v0 = t_frag<2>(vb, 0, d0), v1 = t_frag<2>(vb, 1, d0), v2 = t_frag<2>(vb, 2, d0), v3 = t_frag<2>(vb, 3, d0);
    o[d0] = __builtin_amdgcn_mfma_f32_32x32x16_bf16(pa0, v0, o[d0], 0, 0, 0);
    o[d0] = __builtin_amdgcn_mfma_f32_32x32x16_bf16(pa1, v1, o[d0], 0, 0, 0);
    o[d0] = __builtin_amdgcn_mfma_f32_32x32x16_bf16(pa2, v2, o[d0], 0, 0, 0);
    o[d0] = __builtin_amdgcn_mfma_f32_32x32x16_bf16(pa3, v3, o[d0], 0, 0, 0);
  }
}
__device__ __forceinline__ unsigned f2bf(float f) { unsigned u = __float_as_uint(f); return (u + 0x7fffu + ((u >> 16) & 1u)) >> 16; }

__device__ __forceinline__ void attn_unit(int b, int h, int qb, const bf16_t* Q, const bf16_t* KV, const bf16_t* KR, bf16_t* O, LAS unsigned char* lds, const int wid) {
  const int lane = fresh_lane(), tid = wid * 64 + lane, r32 = lane & 31, hi = lane >> 5;
  LAS unsigned char* V_lds = lds; LAS unsigned char* K_lds = lds + 2 * SHM_V;
  LAS float* ws = (LAS float*)(lds + 2 * SHM_V + 2 * SHM_K) + wid * 64; LAS float* li_l = ws; LAS float* al_l = ws + 32;
  float m_reg = -1e30f, l_reg = 0; f32x16 o[2] = {}; bf16x8 qr[6];
  const size_t tok0 = (size_t)b * SEQ;
  const bf16_t* Qw = Q + (tok0 + qb * 256 + wid * 32 + r32) * NQ + h * 96 + hi * 8;
#pragma unroll
  for (int d0 = 0; d0 < 6; ++d0) qr[d0] = *(const bf16x8*)(Qw + d0 * 16);
  const int srow = tid >> 3, sch = tid & 7;
  const bf16_t* kp = KV + (tok0 + srow) * NKV + h * 128 + sch * 8; const bf16_t* vp = kp + 64; const bf16_t* rp = KR + (tok0 + srow) * 32 + sch * 4;
  const int kst = KSWZ(srow, sch * 16), vst = t_st<2>(srow, sch * 8), rst = KSWZ(srow, 128 + (sch >> 1) * 16) + (sch & 1) * 8;
  const LAS unsigned char* vb0 = V_lds + v_rd_base(lane);
  bf16x8 ksA, vsA, ksB, vsB; u32x2 rsA, rsB;
#define SLOAD(S, k0) do { ks##S = *(const bf16x8*)(kp + (size_t)(k0) * NKV); vs##S = *(const bf16x8*)(vp + (size_t)(k0) * NKV); rs##S = *(const u32x2*)(rp + (size_t)(k0) * 32); } while (0)
#define SWRITE(bf, S) do { *(LAS bf16x8*)(K_lds + (bf) * SHM_K + kst) = ks##S; *(LAS bf16x8*)(V_lds + (bf) * SHM_V + vst) = vs##S; *(LAS u32x2*)(K_lds + (bf) * SHM_K + rst) = rs##S; } while (0)
#define SWAIT() asm volatile("s_waitcnt vmcnt(3)" ::: "memory")
#define RESC(a) do { if (__any((a) < 1.f)) { if (hi == 0) al_l[r32] = (a); LDS_WAIT(); \
    _Pragma("unroll") for (int d = 0; d < 2; ++d) _Pragma("unroll") for (int r = 0; r < 16; ++r) o[d][r] *= al_l[crow(r, hi)]; } } while (0)
#define SBAR() __builtin_amdgcn_sched_barrier(0)
  f32x16 pA0, pA1, pB0, pB1; float mnA, mnB, alA, alB; bf16x8 pa0, pa1, pa2, pa3; constexpr int NT = SEQ / 64;
  SLOAD(A, 0); VM_WAIT(); SWRITE(0, A); __syncthreads();
  qkt(pA0, pA1, K_lds, qr, r32, hi); partialSM(pA0, pA1, m_reg, mnA, alA);
  SLOAD(B, 64); SLOAD(A, 128);
  SWAIT(); SWRITE(1, B); __syncthreads();
  for (int j = 1; j + 1 < NT; j += 2) {
    SBAR(); qkt(pB0, pB1, K_lds + SHM_K, qr, r32, hi);
    finishSM(pA0, pA1, alA, l_reg, pa0, pa1, pa2, pa3); SBAR();
    SLOAD(B, (j + 2) * 64); SBAR();
    pv2(o, vb0, pa0, pa1, pa2, pa3); partialSM(pB0, pB1, m_reg, mnB, alB);
    __syncthreads(); SWAIT(); SWRITE(0, A);
    RESC(alB); __syncthreads();
    SBAR(); qkt(pA0, pA1, K_lds, qr, r32, hi);
    finishSM(pB0, pB1, alB, l_reg, pa0, pa1, pa2, pa3); SBAR();
    if (j + 3 < NT) SLOAD(A, (j + 3) * 64); SBAR();
    pv2(o, vb0 + SHM_V, pa0, pa1, pa2, pa3); partialSM(pA0, pA1, m_reg, mnA, alA);
    __syncthreads(); SWAIT(); SWRITE(1, B);
    RESC(alA); __syncthreads();
  }
  SBAR(); qkt(pB0, pB1, K_lds + SHM_K, qr, r32, hi);
  finishSM(pA0, pA1, alA, l_reg, pa0, pa1, pa2, pa3); SBAR();
  pv2(o, vb0, pa0, pa1, pa2, pa3); partialSM(pB0, pB1, m_reg, mnB, alB);
  __syncthreads(); RESC(alB);
  finishSM(pB0, pB1, alB, l_reg, pa0, pa1, pa2, pa3); SBAR();
  pv2(o, vb0 + SHM_V, pa0, pa1, pa2, pa3);
  if (hi == 0) li_l[r32] = l_reg; LDS_WAIT();
  float rli[16];
#pragma unroll
  for (int r = 0; r < 16; ++r) rli[r] = __builtin_amdgcn_rcpf(li_l[crow(r, hi)]);
  bf16_t* Ow = O + (tok0 + qb * 256 + wid * 32) * 512 + h * 64;
#pragma unroll
  for (int r = 0; r < 16; ++r) { const int orow = crow(r, hi);
#pragma unroll
    for (int d0 = 0; d0 < 2; ++d0) Ow[(size_t)orow * 512 + d0 * 32 + r32] = (bf16_t)f2bf(o[d0][r] * rli[r]); }
  VM_WAIT(); __syncthreads();
#undef SLOAD
#undef SWRITE
#undef SWAIT
#undef RESC
#undef SBAR
}
}

namespace fft {
using attn::crow; using attn::t_st; using attn::t_frag; using attn::v_rd_base; using attn::f2bf;
__device__ __forceinline__ int am64(int row, int k) { return row * 128 + ((((k >> 3) ^ (row & 7))) << 4) + (k & 7) * 2; }
__device__ __forceinline__ int am128(int row, int k) { return row * 256 + ((((k >> 3) ^ (row & 15))) << 4) + (k & 7) * 2; }
constexpr int T_OFF = 0, A_OFF = 65536, TWL_OFF = 65536 + 24576;
__device__ __forceinline__ void stage1(const bf16_t* V, bf16_t* Y, const bf16_t* c64  , const float* tw, LAS unsigned char* lds, int first, int stride, const int wid) {
  const int lane = fresh_lane(), tid = wid * 64 + lane, r32 = lane & 31, hi = lane >> 5;
  LAS unsigned char* T = lds + T_OFF; LAS unsigned char* A = lds + A_OFF; LAS f32x2* twl = (LAS f32x2*)(lds + TWL_OFF);
#pragma unroll
  for (int i = 0; i < 3; ++i) { const int idx = tid + 512 * i, mi = idx >> 9, ch = idx & 511, row = ch >> 3, kc = ch & 7;
    *(LAS u32x4*)(A + mi * 8192 + am64(row, kc * 8)) = *(const u32x4*)(c64 + mi * 4096 + row * 64 + kc * 8); }
  u32x4 st[8];
#define F1_LOAD(u) do { const int b_ = (u) >> 8, b2_ = ((u) >> 1) & 127, hf_ = (u) & 1; \
    _Pragma("unroll") for (int i = 0; i < 8; ++i) { const int idx = tid + 512 * i, a = idx >> 6, n = (idx & 63) * 8; const int gcol = (n < 256) ? hf_ * 256 + n : 512 + hf_ * 256 + (n - 256); \
      st[i] = *(const u32x4*)(V + ((size_t)b_ * SEQ + 128 * a + b2_) * 1024 + gcol); } } while (0)
  int u = first; if (u >= 1024) return;
  F1_LOAD(u);
  for (;;) {
    const int b = u >> 8, b2 = (u >> 1) & 127, hf = u & 1;
#pragma unroll
    for (int i = 0; i < 8; ++i) { const int idx = tid + 512 * i, a = idx >> 6, n = (idx & 63) * 8; *(LAS u32x4*)(T + t_st<16>(a, n)) = st[i]; }
    if (tid < 64) twl[tid] = *(const f32x2*)(tw + ((size_t)tid * 128 + b2) * 2);
    __syncthreads();
    const int un = u + stride; if (un < 1024) F1_LOAD(un);
    const LAS unsigned char* tb = T + v_rd_base(lane);
    {
      asm volatile("" ::: "memory");
      const int nbr = wid, nbi = 8 + wid;
      f32x16 ar[2] = {}, ai[2] = {};
#pragma unroll
      for (int ks = 0; ks < 4; ++ks) {
        const bf16x8 Br = t_frag<16>(tb, ks, nbr), Bi = t_frag<16>(tb, ks, nbi);
#pragma unroll
        for (int mb = 0; mb < 2; ++mb) { const int off = am64(32 * mb + r32, 16 * ks + 8 * hi);
          const bf16x8 Ac = *(const LAS bf16x8*)(A + off), As = *(const LAS bf16x8*)(A + 8192 + off), An = *(const LAS bf16x8*)(A + 16384 + off);
          ar[mb] = __builtin_amdgcn_mfma_f32_32x32x16_bf16(Ac, Br, ar[mb], 0, 0, 0); ar[mb] = __builtin_amdgcn_mfma_f32_32x32x16_bf16(As, Bi, ar[mb], 0, 0, 0);
          ai[mb] = __builtin_amdgcn_mfma_f32_32x32x16_bf16(Ac, Bi, ai[mb], 0, 0, 0); ai[mb] = __builtin_amdgcn_mfma_f32_32x32x16_bf16(An, Br, ai[mb], 0, 0, 0); }
      }
      const int colr = hf * 256 + 32 * wid + r32;
#pragma unroll
      for (int mb = 0; mb < 2; ++mb)
#pragma unroll
        for (int r = 0; r < 16; ++r) { const int c = 32 * mb + crow(r, hi); const f32x2 t = twl[c]; const float yr = ar[mb][r], yi = ai[mb][r];
          bf16_t* dst = Y + (((size_t)b * 64 + c) * 128 + b2) * 1024 + colr;
          dst[0] = (bf16_t)f2bf(yr * t.x + yi * t.y); dst[512] = (bf16_t)f2bf(yi * t.x - yr * t.y); }
    }
    __syncthreads();
    if (un >= 1024) break; u = un;
  }
#undef F1_LOAD
}
__device__ __forceinline__ void stage2(const bf16_t* Y, bf16_t* F, const bf16_t* c128  , LAS unsigned char* lds, int first, int stride, const int wid) {
  const int lane = fresh_lane(), tid = wid * 64 + lane, r32 = lane & 31, hi = lane >> 5;
  LAS unsigned char* T = lds + T_OFF; LAS unsigned char* A = lds + A_OFF;
#pragma unroll
  for (int i = 0; i < 8; ++i) { const int idx = tid + 512 * i, mi = idx >> 11, ch = idx & 2047, row = ch >> 4, kc = ch & 15;
    *(LAS u32x4*)(A + mi * 32768 + am128(row, kc * 8)) = *(const u32x4*)(c128 + mi * 16384 + row * 128 + kc * 8); }
  u32x4 st[8];
#define F2_LOAD(u) do { const int b_ = (u) >> 8, c_ = ((u) >> 2) & 63, qt_ = (u) & 3; \
    _Pragma("unroll") for (int i = 0; i < 8; ++i) { const int idx = tid + 512 * i, row = idx >> 5, n = (idx & 31) * 8; const int gcol = (n < 128) ? qt_ * 128 + n : 512 + qt_ * 128 + (n - 128); \
      st[i] = *(const u32x4*)(Y + (((size_t)b_ * 64 + c_) * 128 + row) * 1024 + gcol); } } while (0)
  int u = first; if (u >= 1024) return;
  F2_LOAD(u);
  for (;;) {
    const int b = u >> 8, c = (u >> 2) & 63, qt = u & 3;
#pragma unroll
    for (int i = 0; i < 8; ++i) { const int idx = tid + 512 * i, row = idx >> 5, n = (idx & 31) * 8; *(LAS u32x4*)(T + t_st<8>(row, n)) = st[i]; }
    __syncthreads();
    const int un = u + stride; if (un < 1024) F2_LOAD(un);
    const LAS unsigned char* tb = T + v_rd_base(lane);
    const int nb = wid & 3, mh = wid >> 2;
    asm volatile("" ::: "memory");
    f32x16 acc[2] = {};
#pragma unroll
    for (int ks = 0; ks < 8; ++ks) {
      const bf16x8 Br = t_frag<8>(tb, ks, nb), Bi = t_frag<8>(tb, ks, 4 + nb);
#pragma unroll
      for (int mb = 0; mb < 2; ++mb) { const int off = am128(64 * mh + 32 * mb + r32, 16 * ks + 8 * hi);
        const bf16x8 Ac = *(const LAS bf16x8*)(A + off), As = *(const LAS bf16x8*)(A + 32768 + off);
        acc[mb] = __builtin_amdgcn_mfma_f32_32x32x16_bf16(Ac, Br, acc[mb], 0, 0, 0); acc[mb] = __builtin_amdgcn_mfma_f32_32x32x16_bf16(As, Bi, acc[mb], 0, 0, 0); }
    }
#pragma unroll
    for (int mb = 0; mb < 2; ++mb)
#pragma unroll
      for (int r = 0; r < 16; ++r) { const int d = 64 * mh + 32 * mb + crow(r, hi);
        F[((size_t)b * SEQ + c + 64 * d) * 512 + qt * 128 + 32 * nb + r32] = (bf16_t)f2bf(acc[mb][r]); }
    __syncthreads();
    if (un >= 1024) break; u = un;
  }
#undef F2_LOAD
}
}

#define XB_TMO      128
#define XB_XCNT(j)  (256  + 64 * (j))
#define XB_XSUB(j)  (1280 + 64 * (j))
#define XB_XGEN(j)  (2304 + 64 * (j))
#define XB_TOP      3328
#define XB_TOPGEN   3392
#define XCD_BAR_WORDS 3456
#define XB_SPIN_CAP (1u << 18)
__device__ __forceinline__ unsigned xb_ld(unsigned* p)              { return __hip_atomic_load(p, __ATOMIC_RELAXED, __HIP_MEMORY_SCOPE_AGENT); }
__device__ __forceinline__ unsigned xb_add(unsigned* p, unsigned v) { return __hip_atomic_fetch_add(p, v, __ATOMIC_RELAXED, __HIP_MEMORY_SCOPE_AGENT); }
__device__ __forceinline__ unsigned xb_xcc_id() { return (unsigned)__builtin_amdgcn_s_getreg((3 << 11) | 20) & 0xFu; }
#define XB_SPIN(cond, bar) do { unsigned _sp = 0; while (cond) { __builtin_amdgcn_s_sleep(1); \
    if ((++_sp & 255u) == 0u) { if (xb_ld(&(bar)[XB_TMO])) break; if (_sp > XB_SPIN_CAP) { atomicAdd(&(bar)[XB_TMO], 1u); break; } } } } while (0)
struct XcdBarrier { unsigned* bar; unsigned x; volatile LAS unsigned* st; };
__device__ __forceinline__ XcdBarrier xcd_barrier_post(unsigned* bar, volatile LAS unsigned* st) {
  XcdBarrier b; b.bar = bar; b.x = xb_xcc_id(); b.st = st;
  if (threadIdx.x == 0) (void)xb_add(&bar[XB_XCNT(b.x)], 1u);
  return b;
}
__device__ __forceinline__ void xcd_barrier_complete(unsigned* bar, unsigned x, unsigned& nloc, unsigned& nx) {
  const unsigned G = gridDim.x * gridDim.y * gridDim.z;
  unsigned sum, cnt, mine, sp = 0u;
  for (;;) {
    sum = 0u; cnt = 0u; mine = 0u;
#pragma unroll
    for (unsigned j = 0; j < 16; ++j) { const unsigned c = xb_ld(&bar[XB_XCNT(j)]); sum += c; cnt += (c > 0u) ? 1u : 0u; mine = (j == x) ? c : mine; }
    if (sum == G) break;
    __builtin_amdgcn_s_sleep(1);
    if ((++sp & 255u) == 0u) { if (xb_ld(&bar[XB_TMO])) break; if (sp > XB_SPIN_CAP) { atomicAdd(&bar[XB_TMO], 1u); break; } }
  }
  nloc = mine > 0u ? mine : 1u; nx = cnt > 0u ? cnt : 1u;
}
__device__ __forceinline__ void xcd_barrier(const XcdBarrier& b) {
  asm volatile("s_waitcnt vmcnt(0)" ::: "memory");
  __syncthreads();
  if (threadIdx.x == 0) {
    unsigned* bar = b.bar;
    __builtin_amdgcn_s_waitcnt(0);
    unsigned nloc = b.st[0], nx = b.st[1];
    if (nloc == 0u) { xcd_barrier_complete(bar, b.x, nloc, nx); b.st[0] = nloc; b.st[1] = nx; }
    const unsigned old = xb_add(&bar[XB_XSUB(b.x)], 1u);
    const unsigned gen = old / nloc;
    if (old + 1u == (gen + 1u) * nloc) {
      __builtin_amdgcn_fence(__ATOMIC_RELEASE, "agent");
      asm volatile("s_waitcnt vmcnt(0)" ::: "memory");
      const unsigned og = xb_add(&bar[XB_TOP], 1u);
      const unsigned tg = og / nx;
      if (og + 1u == (tg + 1u) * nx) xb_add(&bar[XB_TOPGEN], 1u);
      else XB_SPIN(xb_ld(&bar[XB_TOPGEN]) == tg, bar);
      __builtin_amdgcn_fence(__ATOMIC_ACQUIRE, "agent");
      xb_add(&bar[XB_XGEN(b.x)], 1u);
      asm volatile("s_waitcnt vmcnt(0)" ::: "memory");
    } else {
      XB_SPIN(xb_ld(&bar[XB_XGEN(b.x)]) == gen, bar);
      __builtin_amdgcn_fence(__ATOMIC_ACQUIRE, "agent");
      asm volatile("s_waitcnt vmcnt(0)" ::: "memory");
    }
  }
  __syncthreads();
}

constexpr int NWAVES = 8;
constexpr int RING_BYTES = 131072, LDSCTL_OFF = RING_BYTES, MISC_OFF = LDSCTL_OFF + 320, FOLD_OFF = RING_BYTES + 1024;
constexpr int LDS_BYTES = 147456;
struct Args { const float* in[23]; float* out; unsigned char* ws; int ph_lo, ph_hi; };
struct Frame {
  LAS unsigned char* lds; int wave, vcu, G;
  const float* const* in; float* out; unsigned char* ws;
};

__device__ __forceinline__ void p0_transpose_item(const float* W, int ldw, int k0, int n0, bf16_t* WT, int ldwt, int drow0, bool perm, const float* kscale, float cscale, LAS float* scr, int lane) {
#pragma unroll 8
  for (int i = 0; i < 32; ++i) { const int kk = 2 * i + (lane >> 5); float v = W[(size_t)(k0 + kk) * ldw + n0 + (lane & 31)]; if (kscale) v *= kscale[k0 + kk]; scr[kk * 33 + (lane & 31)] = v * cscale; }
  LDS_WAIT(); asm volatile("" ::: "memory");
  const int c = lane & 7;
#pragma unroll
  for (int j = 0; j < 4; ++j) { const int n = (lane >> 3) + 8 * j; const LAS float* s = scr + (8 * c) * 33 + n;
    u32x4 o; o.x = cvt_pk_bf16(s[0 * 33], s[1 * 33]); o.y = cvt_pk_bf16(s[2 * 33], s[3 * 33]); o.z = cvt_pk_bf16(s[4 * 33], s[5 * 33]); o.w = cvt_pk_bf16(s[6 * 33], s[7 * 33]);
    const int dr = drow0 + (perm ? (n < 16 ? 2 * n : 2 * (n - 16) + 1) : n);
    *(u32x4*)(WT + (size_t)dr * ldwt + k0 + 8 * c) = o; }
  LDS_WAIT(); asm volatile("" ::: "memory");
}
constexpr int I_GU = 16 * 88, I_DN = 44 * 32, I_WIN = 16 * 85, I_WQ = 6 * 24, I_WKV = 4 * 32, I_WF = 8 * 32, I_WO = 16 * 32;
constexpr int NTRANS = 4 * I_GU + 2 * I_DN + I_WIN + I_WQ + I_WKV + 2 * I_WF + I_WO;
constexpr int NMODI = 144 * 32;
__device__ __forceinline__ void p0_trans_dispatch(const Frame& F, int r, LAS float* scr) {
  unsigned char* ws = F.ws; const int lane = fresh_lane();
  if (r < 4 * I_GU) { const int j = r / I_GU, it = r % I_GU, kb = it / 88, nb = it % 88, n0 = nb * 32;
    const float* W = j == 0 ? F.in[6] : j == 1 ? F.in[7] : j == 2 ? F.in[19] : F.in[20]; bf16_t* WT = (bf16_t*)(ws + (j < 2 ? WS_WGU1 : WS_WGU2));
    p0_transpose_item(W, DFF, kb * 64, n0, WT, DM, (n0 >> 7) * 256 + (j & 1) * 128 + (n0 & 127), false, nullptr, 1.f, scr, lane); return; }
  r -= 4 * I_GU;
  if (r < 2 * I_DN) { const int j = r / I_DN, it = r % I_DN, kb = it / 32, nb = it % 32;
    p0_transpose_item(j ? F.in[21] : F.in[8], DM, kb * 64, nb * 32, (bf16_t*)(ws + (j ? WS_WD2 : WS_WD1)), DFF, nb * 32, false, nullptr, 1.f, scr, lane); return; }
  r -= 2 * I_DN;
  if (r < I_WIN) { const int kb = r / 85, nb = r % 85, n0 = 512 + nb * 32; int dr; bool perm = false;
    if (n0 < 896) dr = 3072 + (n0 - 512); else if (n0 < 1152) dr = 3456 + (n0 - 896); else if (n0 < 1184) { dr = 3712; perm = true; } else dr = 1024 + (n0 - 1184);
    p0_transpose_item(F.in[10], 3232, kb * 64, n0, (bf16_t*)(ws + WS_WIN), DM, dr, perm, nullptr, 1.f, scr, lane); return; }
  r -= I_WIN;
  if (r < I_WQ) { const int kb = r / 24, nb = r % 24, n0 = nb * 32;
    p0_transpose_item(F.in[12], NQ, kb * 64, n0, (bf16_t*)(ws + WS_WQ), QLR, n0, (n0 % 96) == 64, F.in[11], SCQ, scr, lane); return; }
  r -= I_WQ;
  if (r < I_WKV) { const int kb = r / 32, nb = r % 32;
    p0_transpose_item(F.in[14], NKV, kb * 64, nb * 32, (bf16_t*)(ws + WS_WKV), KVLR, nb * 32, false, F.in[13], 1.f, scr, lane); return; }
  r -= I_WKV;
  if (r < 2 * I_WF) { const int j = r / I_WF, it = r % I_WF, kb = it / 32, nb = it % 32;
    p0_transpose_item(j ? F.in[16] : F.in[15], DM, kb * 64, nb * 32, (bf16_t*)(ws + (j ? WS_WM : WS_WF)), 512, nb * 32, false, nullptr, 1.f, scr, lane); return; }
  r -= 2 * I_WF;
  { const int kb = r / 32, nb = r % 32;
    p0_transpose_item(F.in[17], DM, kb * 64, nb * 32, (bf16_t*)(ws + WS_WO), DM, nb * 32, false, nullptr, 1.f, scr, lane); }
}
__device__ __forceinline__ void p0_mod_item(const Frame& F, int it) {
  const int nb = it % 144, kc = it / 144, n = nb * 64 + fresh_lane(); const float* cin = F.in[1]; const float* W = F.in[3] + (size_t)(kc * 32) * NADA + n;
  float acc[4] = {0.f, 0.f, 0.f, 0.f};
#pragma unroll 8
  for (int kk = 0; kk < 32; ++kk) { const float w = W[(size_t)kk * NADA];
#pragma unroll
    for (int b = 0; b < 4; ++b) { const float cv = cin[b * DM + kc * 32 + kk]; acc[b] += cv * fast_sigmoid(cv) * w; } }
  float* mod = (float*)(F.ws + OFF_MOD);
#pragma unroll
  for (int b = 0; b < 4; ++b) { float v = acc[b]; if (kc == 0) v += F.in[4][n]; __hip_atomic_fetch_add(mod + b * NADA + n, v, __ATOMIC_RELAXED, __HIP_MEMORY_SCOPE_AGENT); }
}
__device__ __forceinline__ void p0_fold_item(const Frame& F, int it) {
  LAS float* tile = (LAS float*)(F.lds + FOLD_OFF); LAS float* cosT = tile + 2048;
  const int kc = it >> 2, g = it & 3, k0 = kc * 16, tid = F.wave * 64 + fresh_lane();
  { const int idx = tid * 4, kk = idx >> 7, c = idx & 127; *(LAS f32x4*)(tile + idx) = *(const f32x4*)(F.in[10] + (size_t)(k0 + kk) * 3232 + g * 128 + c); }
  if (tid < 128) cosT[tid] = __builtin_amdgcn_cosf((float)tid * (1.0f / 128.0f)) * 0.08838834764831845f;
  __syncthreads();
  const int n = tid & 255, ri = n >> 7, m = n & 127, kh = tid >> 8;
  float acc[8] = {0.f, 0.f, 0.f, 0.f, 0.f, 0.f, 0.f, 0.f};
  for (int c = 0; c < 128; ++c) { const int idx = (m * c) & 127; const float tv = ri ? -cosT[(idx - 32) & 127] : cosT[idx];
#pragma unroll
    for (int q = 0; q < 8; ++q) acc[q] += tile[(kh * 8 + q) * 128 + c] * tv; }
  u32x4 o; o.x = cvt_pk_bf16(acc[0], acc[1]); o.y = cvt_pk_bf16(acc[2], acc[3]); o.z = cvt_pk_bf16(acc[4], acc[5]); o.w = cvt_pk_bf16(acc[6], acc[7]);
  *(u32x4*)((bf16_t*)(F.ws + WS_WIN) + (size_t)(ri * 512 + g * 128 + m) * DM + k0 + kh * 8) = o;
  __syncthreads();
}
__device__ __forceinline__ void p0_prologue(const Frame& F) {
  unsigned char* ws = F.ws;
  for (int it = blockIdx.x; it < 256; it += F.G) p0_fold_item(F, it);
  LAS float* scr = (LAS float*)(F.lds + F.wave * 16384);
  const int gw = F.vcu * NWAVES + F.wave, NGW = F.G * NWAVES;
  for (int it = gw; it < NMODI; it += NGW) p0_mod_item(F, it);
  for (int it = gw; it < NTRANS; it += NGW) p0_trans_dispatch(F, it, scr);
  const int gt = blockIdx.x * 512 + F.wave * 64 + fresh_lane(), NGT = F.G * 512;
  { const int* pos = (const int*)F.in[2]; float* rope = (float*)(ws + WS_ROPE);
    for (int e = gt; e < MTOK * 16; e += NGT) { const int tok = e >> 4, j = e & 15;
      const double c4 = (j & 3) == 0 ? 1.0 : (j & 3) == 1 ? 0.5623413251903491 : (j & 3) == 2 ? 0.31622776601683794 : 0.1778279410038923;
      const double p10 = (j >> 2) == 0 ? 1.0 : (j >> 2) == 1 ? 0.1 : (j >> 2) == 2 ? 0.01 : 0.001;
      const float inv = (float)(c4 * p10); const float ang = (float)pos[tok] * inv;
      double t = (double)ang * 0.15915494309189535; t -= __builtin_floor(t); const float tf = (float)t;
      rope[(size_t)tok * 32 + j] = __builtin_amdgcn_cosf(tf); rope[(size_t)tok * 32 + 16 + j] = __builtin_amdgcn_sinf(tf); } }
  { float* tw = (float*)(ws + WS_TW);
    for (int e = gt; e < 64 * 128; e += NGT) { const int c = e >> 7, b2 = e & 127; const float t = (float)((c * b2) & 8191) * (1.0f / 8192.0f);
      tw[2 * e] = __builtin_amdgcn_cosf(t); tw[2 * e + 1] = __builtin_amdgcn_sinf(t); } }
  { bf16_t* c64 = (bf16_t*)(ws + WS_C64);
    for (int e = gt; e < 4096; e += NGT) { const int c = e >> 6, a = e & 63; const float t = (float)((c * a) & 63) * (1.0f / 64.0f);
      const float cs = __builtin_amdgcn_cosf(t) * 0.125f, sn = __builtin_amdgcn_sinf(t) * 0.125f;
      c64[e] = (bf16_t)attn::f2bf(cs); c64[4096 + e] = (bf16_t)attn::f2bf(sn); c64[8192 + e] = (bf16_t)attn::f2bf(-sn); } }
  { bf16_t* c128 = (bf16_t*)(ws + WS_C128);
    for (int e = gt; e < 16384; e += NGT) { const int d = e >> 7, b2 = e & 127; const float t = (float)((d * b2) & 127) * (1.0f / 128.0f);
      c128[e] = (bf16_t)attn::f2bf(__builtin_amdgcn_cosf(t) * 0.08838834764831845f); c128[16384 + e] = (bf16_t)attn::f2bf(__builtin_amdgcn_sinf(t) * 0.08838834764831845f); } }
  { u32x4* z = (u32x4*)((bf16_t*)(ws + WS_WIN) + (size_t)3744 * DM);
    for (int e = gt; e < 96 * DM / 8; e += NGT) z[e] = (u32x4){0u, 0u, 0u, 0u}; }
}
__device__ __forceinline__ void norm_mod_phase(const Frame& F, const float* x, const float* g, const float* mod_shift, const float* mod_scale, bf16_t* H) {
  const int gw = F.vcu * NWAVES + F.wave, NGW = F.G * NWAVES, lane = fresh_lane();
  for (int ch = gw; ch < MTOK / 16; ch += NGW) {
    const int row0 = ch * 16, b = row0 / SEQ;
    f32x4 av[4], bv[4];
#pragma unroll
    for (int j = 0; j < 4; ++j) { const int col = 4 * lane + 256 * j; const f32x4 gg = *(const f32x4*)(g + col), sc = *(const f32x4*)(mod_scale + (size_t)b * NADA + col);
      av[j] = gg * (1.0f + sc); bv[j] = *(const f32x4*)(mod_shift + (size_t)b * NADA + col); }
    for (int r = 0; r < 16; ++r) {
      const f32x4* xr = (const f32x4*)(x + (size_t)(row0 + r) * DM) + lane; f32x4 v[4]; float s = 0.f;
#pragma unroll
      for (int j = 0; j < 4; ++j) { v[j] = xr[64 * j]; s += (v[j][0] * v[j][0] + v[j][1] * v[j][1]) + (v[j][2] * v[j][2] + v[j][3] * v[j][3]); }
      const float rs = rsqrtf(wave_sum(s) * (1.0f / DM) + NORM_EPS);
      u32x2* o8 = (u32x2*)(H + (size_t)(row0 + r) * DM) + lane;
#pragma unroll
      for (int j = 0; j < 4; ++j) { const f32x4 y = v[j] * rs * av[j] + bv[j]; u32x2 w; w.x = cvt_pk_bf16(y[0], y[1]); w.y = cvt_pk_bf16(y[2], y[3]); o8[64 * j] = w; }
    }
  }
}
__device__ __forceinline__ void final_norm_phase(const Frame& F, float* x, const float* g) {
  const int gw = F.vcu * NWAVES + F.wave, NGW = F.G * NWAVES, lane = fresh_lane();
  f32x4 gv[4];
#pragma unroll
  for (int j = 0; j < 4; ++j) gv[j] = *(const f32x4*)(g + 4 * lane + 256 * j);
  for (int row = gw; row < MTOK; row += NGW) {
    f32x4* xr = (f32x4*)(x + (size_t)row * DM) + lane; f32x4 v[4]; float s = 0.f;
#pragma unroll
    for (int j = 0; j < 4; ++j) { v[j] = xr[64 * j]; s += (v[j][0] * v[j][0] + v[j][1] * v[j][1]) + (v[j][2] * v[j][2] + v[j][3] * v[j][3]); }
    const float rs = rsqrtf(wave_sum(s) * (1.0f / DM) + NORM_EPS);
#pragma unroll
    for (int j = 0; j < 4; ++j) xr[64 * j] = v[j] * rs * gv[j];
  }
}

constexpr int NPHASE = 14;
__global__ void __launch_bounds__(NWAVES * 64, 2) mk_fwd(Args args) {
  extern __shared__ __attribute__((aligned(16))) unsigned char lds_raw[];
  Frame F;
  F.lds = (LAS unsigned char*)lds_raw; F.wave = __builtin_amdgcn_readfirstlane(threadIdx.x >> 6);
  F.G = gridDim.x; { const int bx = blockIdx.x; F.vcu = (F.G % 8 == 0) ? (bx % 8) * (F.G / 8) + bx / 8 : bx; }
  F.in = args.in; F.out = args.out; F.ws = args.ws;
  unsigned char* ws = args.ws;
  for (int u = threadIdx.x; u < (LDS_BYTES - LDSCTL_OFF) / 4; u += NWAVES * 64) ((LAS unsigned*)(F.lds + LDSCTL_OFF))[u] = 0u;
  __syncthreads();
#if MK_SINGLE
  XcdBarrier bar = xcd_barrier_post((unsigned*)(ws + WS_CTL) + CW_BAR, (volatile LAS unsigned*)(F.lds + MISC_OFF) + 8);
#define GRID_BAR() xcd_barrier(bar)
#else
#define GRID_BAR() do {} while (0)
#endif
  const int lo = args.ph_lo, hi = args.ph_hi;
#ifndef PH_MASK
#define PH_MASK 0xFFFF
#endif
#define IN(k) (((PH_MASK >> (k)) & 1) && lo <= (k) && (k) < hi)
#define SEAM(k) do { if (IN(k) && IN((k) + 1)) GRID_BAR(); } while (0)
  const float* mod = (const float*)(ws + OFF_MOD);
  float* rsq_q = (float*)(ws + OFF_RSQQ); float* rsq_kv = (float*)(ws + OFF_RSQKV);
  const float* rope = (const float*)(ws + WS_ROPE);
  bf16_t* H = (bf16_t*)(ws + WS_H); bf16_t* ACT = (bf16_t*)(ws + WS_BIG);
  bf16_t* Vb = (bf16_t*)(ws + WS_V); bf16_t* Yb = (bf16_t*)(ws + WS_Y); bf16_t* Fb = (bf16_t*)(ws + WS_F); bf16_t* ZL = (bf16_t*)(ws + WS_ZL); bf16_t* Ob = (bf16_t*)(ws + WS_O);
  bf16_t* Qb = (bf16_t*)(ws + WS_H); bf16_t* KVb = (bf16_t*)(ws + WS_KV); bf16_t* KRb = (bf16_t*)(ws + WS_KR); bf16_t* GT = (bf16_t*)(ws + WS_GATES); bf16_t* YM = (bf16_t*)(ws + WS_H);
  const int cu = (int)blockIdx.x;

  if (IN(0)) { p0_prologue(F); } SEAM(0);
  if (IN(1)) { norm_mod_phase(F, F.in[0], F.in[5], mod + 0 * DM, mod + 1 * DM, H); } SEAM(1);
  if (IN(2)) { pg8::Gemm g{H, (const bf16_t*)(ws + WS_WGU1), MTOK, 2 * DFF, DM, DM, DM}; pg8::StaticOrder S; S.init(MTOK, 2 * DFF, F.G, cu);
    pg8::EpiSwiglu E{ACT}; pg8::gemm_phase(F.lds, g, S, E, F.wave); } SEAM(2);
  if (IN(3)) { pg8::Gemm g{ACT, (const bf16_t*)(ws + WS_WD1), MTOK, DM, DFF, DFF, DFF}; pg8::StaticOrder S; S.init(MTOK, DM, F.G, cu);
    pg8::EpiResid E{F.in[0], F.out, mod + 2 * DM, 0.5f}; pg8::gemm_phase(F.lds, g, S, E, F.wave); } SEAM(3);
  if (IN(4)) { norm_mod_phase(F, F.out, F.in[9], mod + 3 * DM, mod + 4 * DM, H); } SEAM(4);
  if (IN(5)) { pg8::Gemm g{H, (const bf16_t*)(ws + WS_WIN), MTOK, NWIN, DM, DM, DM}; pg8::StaticOrder S; S.init(MTOK, NWIN, F.G, cu);
    pg8::EpiWin E{Vb, GT, ZL, KRb, rsq_q, rsq_kv, rope}; pg8::gemm_phase(F.lds, g, S, E, F.wave); } SEAM(5);
#ifndef P6_PART
#define P6_PART 7
#endif
  if (IN(6)) {
    if (P6_PART & 1) { pg8::Gemm g{ZL, (const bf16_t*)(ws + WS_WQ), MTOK, NQ, QLR, ZLW, QLR}; pg8::StaticOrder S; S.init(MTOK, NQ, F.G, cu);
      pg8::EpiQ E{Qb, rsq_q, rope}; pg8::gemm_phase(F.lds, g, S, E, F.wave); }
    if (P6_PART & 2) { pg8::Gemm g{ZL + QLR, (const bf16_t*)(ws + WS_WKV), MTOK, NKV, KVLR, ZLW, KVLR}; pg8::StaticOrder S; S.init(MTOK, NKV, F.G, F.G - 1 - cu);
      pg8::EpiKV E{KVb, rsq_kv}; pg8::gemm_phase(F.lds, g, S, E, F.wave); }
    if (P6_PART & 4) fft::stage1(Vb, Yb, (const bf16_t*)(ws + WS_C64), (const float*)(ws + WS_TW), F.lds, F.vcu, F.G, F.wave);
  } SEAM(6);
  if (IN(7)) {
    fft::stage2(Yb, Fb, (const bf16_t*)(ws + WS_C128), F.lds, F.vcu, F.G, F.wave);
    { const int xl = F.vcu >> 5, qb = F.vcu & 31;
      for (int i = 0; i < 4; ++i) { const int bh = xl + 8 * i; if (F.G == 256) attn::attn_unit(bh >> 3, bh & 7, qb, Qb, KVb, KRb, Ob, F.lds, F.wave); }
      if (F.G != 256) for (int uu = cu; uu < 1024; uu += F.G) attn::attn_unit(uu >> 8, (uu >> 5) & 7, uu & 31, Qb, KVb, KRb, Ob, F.lds, F.wave); }
  } SEAM(7);
#ifndef MERGE_PART
#define MERGE_PART 3
#endif
  if (IN(8)) {
#ifndef DBG_SRC
#define DBG_SRC 0
#endif
    if (MERGE_PART & 1) { pg8::Gemm g{DBG_SRC == 1 ? Vb : DBG_SRC == 2 ? Yb : Fb, (const bf16_t*)(ws + WS_WF), MTOK, DM, 512, DBG_SRC ? 1024 : 512, 512}; pg8::StaticOrder S; S.init(MTOK, DM, F.G, cu);
      pg8::EpiMerge<false, 0> E{YM, GT}; pg8::gemm_phase(F.lds, g, S, E, F.wave); }
    if (MERGE_PART == 3) { pg8::Gemm g{Ob, (const bf16_t*)(ws + WS_WM), MTOK, DM, 512, 512, 512}; pg8::StaticOrder S; S.init(MTOK, DM, F.G, cu);
      pg8::EpiMerge<true, 1024> E{YM, GT}; pg8::gemm_phase(F.lds, g, S, E, F.wave); }
    if (MERGE_PART == 2) { pg8::Gemm g{Ob, (const bf16_t*)(ws + WS_WM), MTOK, DM, 512, 512, 512}; pg8::StaticOrder S; S.init(MTOK, DM, F.G, cu);
      pg8::EpiMerge<false, 1024> E{YM, GT}; pg8::gemm_phase(F.lds, g, S, E, F.wave); }
  } SEAM(8);
  if (IN(9)) { pg8::Gemm g{YM, (const bf16_t*)(ws + WS_WO), MTOK, DM, DM, DM, DM}; pg8::StaticOrder S; S.init(MTOK, DM, F.G, cu);
    pg8::EpiResid E{F.out, F.out, mod + 5 * DM, 1.0f}; pg8::gemm_phase(F.lds, g, S, E, F.wave); } SEAM(9);
  if (IN(10)) { norm_mod_phase(F, F.out, F.in[18], mod + 6 * DM, mod + 7 * DM, H); } SEAM(10);
  if (IN(11)) { pg8::Gemm g{H, (const bf16_t*)(ws + WS_WGU2), MTOK, 2 * DFF, DM, DM, DM}; pg8::StaticOrder S; S.init(MTOK, 2 * DFF, F.G, cu);
    pg8::EpiSwiglu E{ACT}; pg8::gemm_phase(F.lds, g, S, E, F.wave); } SEAM(11);
  if (IN(12)) { pg8::Gemm g{ACT, (const bf16_t*)(ws + WS_WD2), MTOK, DM, DFF, DFF, DFF}; pg8::StaticOrder S; S.init(MTOK, DM, F.G, cu);
    pg8::EpiResid E{F.out, F.out, mod + 8 * DM, 0.5f}; pg8::gemm_phase(F.lds, g, S, E, F.wave); } SEAM(12);
  if (IN(13)) { final_norm_phase(F, F.out, F.in[22]); }
#undef IN
#undef SEAM
}

extern "C" void kernel_launch(void* const* d_in, const int* in_sizes, int n_in, void* d_out, int out_size, void* d_ws, size_t ws_size, hipStream_t stream) {
  static int grid = 0;
  if (grid == 0) {
    if (n_in != 23 || in_sizes[0] != MTOK * DM || out_size != MTOK * DM || ws_size < WS_END) {
      fprintf(stderr, "kernel_launch: unexpected shapes n_in %d in0 %d out %d ws %zu (need >= %zu)\n", n_in, n_in > 0 ? in_sizes[0] : -1, out_size, ws_size, (size_t)WS_END); grid = -1; return; }
    int dev = 0, cus = 0;
    if (hipGetDevice(&dev) != hipSuccess || hipDeviceGetAttribute(&cus, hipDeviceAttributeMultiprocessorCount, dev) != hipSuccess) { grid = -1; return; }
    if (hipFuncSetAttribute((const void*)mk_fwd, hipFuncAttributeMaxDynamicSharedMemorySize, LDS_BYTES) != hipSuccess) { fprintf(stderr, "kernel_launch: hipFuncSetAttribute failed\n"); grid = -1; return; }
    grid = cus;
  }
  if (grid < 0) return;
  (void)hipMemsetAsync((char*)d_ws + WS_CTL, 0, CTL_ZERO_BYTES, stream);
  Args a{};
  for (int i = 0; i < 23; ++i) a.in[i] = (const float*)d_in[i];
  a.out = (float*)d_out; a.ws = (unsigned char*)d_ws;
#if MK_SINGLE
  a.ph_lo = 0; a.ph_hi = NPHASE;
  hipLaunchKernelGGL(mk_fwd, dim3(grid), dim3(NWAVES * 64), LDS_BYTES, stream, a);
#else
  for (int p = 0; p < NPHASE; ++p) { a.ph_lo = p; a.ph_hi = p + 1; hipLaunchKernelGGL(mk_fwd, dim3(grid), dim3(NWAVES * 64), LDS_BYTES, stream, a); }
#endif
}
```

```cpp
#include <hip/hip_runtime.h>
#include <cstdio>
#include <cstdint>

#define LAS __attribute__((address_space(3)))
#define GAS __attribute__((address_space(1)))
typedef unsigned short bf16_t;
typedef short bf16x8 __attribute__((ext_vector_type(8)));
typedef short s16x4 __attribute__((ext_vector_type(4)));
typedef float f32x4 __attribute__((ext_vector_type(4)));
typedef float f32x2 __attribute__((ext_vector_type(2)));
typedef float f32x16 __attribute__((ext_vector_type(16)));
typedef unsigned u32x4 __attribute__((ext_vector_type(4)));
typedef unsigned u32x2 __attribute__((ext_vector_type(2)));

#ifndef MK_SINGLE
#define MK_SINGLE 1
#endif

constexpr int BATCH = 4, SEQ = 8192, DM = 1024, MTOK = BATCH * SEQ, DFF = 2816, NADA = 9 * DM;
constexpr int NWIN = 3840;
constexpr int QLR = 384, KVLR = 256, NQ = 768, NKV = 1024, ZLW = 768;
constexpr float NORM_EPS = 1e-6f;
constexpr float SCQ = 0.10206207261596575f * 1.4426950408889634f;

constexpr size_t MiB = 1u << 20;
constexpr size_t WS_CTL = 0, CTL_ZERO_BYTES = 2 * MiB;
constexpr size_t OFF_MOD = 256 * 1024, OFF_RSQQ = 512 * 1024, OFF_RSQKV = 640 * 1024;
constexpr size_t WS_ROPE = 2 * MiB;
constexpr size_t WS_TW = 6 * MiB;
constexpr size_t WS_C64 = 6 * MiB + 64 * 1024, WS_S64 = WS_C64 + 8192, WS_NS64 = WS_S64 + 8192;
constexpr size_t WS_C128 = 6 * MiB + 128 * 1024, WS_S128 = WS_C128 + 32768;
constexpr size_t WS_WGU1 = 8 * MiB, WS_WD1 = 19 * MiB, WS_WGU2 = 25 * MiB, WS_WD2 = 36 * MiB, WS_WIN = 42 * MiB;
constexpr size_t WS_WQ = 50 * MiB, WS_WKV = 51 * MiB, WS_WF = 52 * MiB, WS_WM = 53 * MiB, WS_WO = 54 * MiB;
constexpr size_t WS_H = 64 * MiB;
constexpr size_t WS_KV = 128 * MiB;
constexpr size_t WS_GATES = 192 * MiB;
constexpr size_t WS_KR = 320 * MiB;
constexpr size_t WS_BIG = 322 * MiB;
constexpr size_t WS_V = WS_BIG, WS_F = WS_BIG, WS_Y = WS_BIG + 64 * MiB, WS_ZL = WS_BIG + 128 * MiB, WS_O = WS_ZL;
constexpr size_t WS_END = 498 * MiB;
constexpr int CW_BAR = 4096;

typedef __bf16 bf16x2_t __attribute__((ext_vector_type(2)));
__device__ __forceinline__ unsigned cvt_pk_bf16(float lo, float hi) { f32x2 v = {lo, hi}; bf16x2_t b = __builtin_convertvector(v, bf16x2_t); return __builtin_bit_cast(unsigned, b); }
__device__ __forceinline__ float bf_lo(unsigned w) { return __uint_as_float(w << 16); }
__device__ __forceinline__ float bf_hi(unsigned w) { return __uint_as_float(w & 0xffff0000u); }
__device__ __forceinline__ u32x4 pack8(f32x4 a, f32x4 b) { u32x4 w; w.x = cvt_pk_bf16(a[0], a[1]); w.y = cvt_pk_bf16(a[2], a[3]); w.z = cvt_pk_bf16(b[0], b[1]); w.w = cvt_pk_bf16(b[2], b[3]); return w; }
__device__ __forceinline__ float fast_sigmoid(float v) { return __builtin_amdgcn_rcpf(1.0f + __builtin_amdgcn_exp2f(-1.4426950408889634f * v)); }
__device__ __forceinline__ float wave_sum(float v) {
#pragma unroll
  for (int o = 1; o < 64; o <<= 1) v += __shfl_xor(v, o);
  return v;
}
__device__ __forceinline__ int fresh_lane() { int l; asm volatile("v_mbcnt_lo_u32_b32 %0, -1, 0\n\tv_mbcnt_hi_u32_b32 %0, -1, %0" : "=v"(l)); return l; }
#define LDS_WAIT() asm volatile("s_waitcnt lgkmcnt(0)" ::: "memory")
#define VM_WAIT() asm volatile("s_waitcnt vmcnt(0)" ::: "memory")

namespace pg8 {
constexpr int BM = 256, BK = 64, HALF = 128, HTB = HALF * BK * 2, STAGE_BYTES = 8 * HTB, NXCD = 8, WGM = 8;
__host__ __device__ __forceinline__ int lds_byte(int r, int c) { const int st = (r >> 4) * 2 + (c >> 5), rr = r & 15, cc = c & 31, ob = rr * 64 + cc * 2; return st * 1024 + (ob ^ (((ob >> 9) & 1) << 5)); }
__host__ __device__ __forceinline__ void stage_rc(int b, int& R, int& C) { const int st = b / 1024, sb = b % 1024, swz = sb ^ (((sb >> 9) & 1) << 5); R = (st >> 1) * 16 + swz / 64; C = (st & 1) * 32 + (swz % 64) / 2; }
__host__ __device__ __forceinline__ int perm32(int rho) { const int n = rho >> 4, i = rho & 15; return 8 * (i >> 2) + 4 * n + (i & 3); }
struct Unit { int pm, pn; };
struct Gemm { const bf16_t* A; const bf16_t* Bt; int M, N, K, lda, ldb; };
struct StaticOrder {
  int nM, nN, nwg, G, c;
  __host__ __device__ void init(int M, int N, int G_, int c_) { nM = M / BM; nN = N / BM; nwg = nM * nN; G = G_; c = c_; }
  __host__ __device__ bool next(int i, Unit& u) const {
    const long L = (long)i * G + c; if (L >= nwg) return false;
    int wgid = (int)L; { const int q = nwg / NXCD, r = nwg % NXCD, xcd = wgid % NXCD, off = wgid / NXCD; wgid = (xcd < r ? xcd * (q + 1) : r * (q + 1) + (xcd - r) * q) + off; }
    const int nig = WGM * nN, gid = wgid / nig, fm = gid * WGM, gsz = (nM - fm) < WGM ? (nM - fm) : WGM;
    u.pm = fm + ((wgid % nig) % gsz); u.pn = (wgid % nig) / gsz; return true;
  }
};
template <class Epi, class Sched, bool ALIGN_EPI = true, bool SP2 = true>
__device__ __forceinline__ void gemm_phase(LAS unsigned char* lds, const Gemm g, const Sched& S, const Epi& E, const int wid) {
  const int lane0 = fresh_lane();
  const int tid = wid * 64 + lane0, wr = wid >> 2, wc = wid & 3, fr = lane0 & 15, fq = lane0 >> 4;
  const int K = g.K, nt = K / BK;
  unsigned voffA[2], voffB[2];
#pragma unroll
  for (int i = 0; i < 2; ++i) { int R, C; stage_rc(tid * 16 + i * 8192, R, C); const int Rb = Epi::PERM ? ((R & ~31) + perm32(R & 31)) : R;
    voffA[i] = (unsigned)(R * g.lda + C) * 2u; voffB[i] = (unsigned)(Rb * g.ldb + C) * 2u; }
  const size_t kstep = (size_t)(BK * 2);
  const size_t hstepA = (size_t)HALF * g.lda * 2, hstepB = (size_t)HALF * g.ldb * 2;
  const size_t tstepA = 2 * hstepA, tstepB = 2 * hstepB;
  const unsigned ldsw = (unsigned)wid * 1024u;
  const int aoff = lds_byte(wr * 64 + fr, fq * 8), boff = lds_byte(wc * 32 + fr, fq * 8);
#define PG8_SA(b, h) (((b) * 2 + (h)) * HTB)
#define PG8_SB(b, h) ((4 + (b) * 2 + (h)) * HTB)
#define PG8_STAGE(bufoff, gbase, voff) do { _Pragma("unroll") for (int _i = 0; _i < 2; ++_i) \
    __builtin_amdgcn_global_load_lds((const unsigned*)((const char*)(gbase) + (voff)[_i]), (LAS unsigned*)(lds + (bufoff) + ldsw + _i * 8192), 16, 0, 0); } while (0)
#define PG8_LDA(dst, b, h) do { _Pragma("unroll") for (int m = 0; m < 4; ++m) _Pragma("unroll") for (int k = 0; k < 2; ++k) dst[m][k] = *(const LAS bf16x8*)(lds + PG8_SA(b, h) + aoff + m * 2048 + k * 1024); } while (0)
#define PG8_LDB(dst, b, h) do { _Pragma("unroll") for (int n = 0; n < 2; ++n) _Pragma("unroll") for (int k = 0; k < 2; ++k) dst[n][k] = *(const LAS bf16x8*)(lds + PG8_SB(b, h) + boff + n * 2048 + k * 1024); } while (0)
#define PG8_MMA(ai, bj, At, Bt) do { __builtin_amdgcn_s_setprio(1); _Pragma("unroll") for (int m = 0; m < 4; ++m) _Pragma("unroll") for (int n = 0; n < 2; ++n) _Pragma("unroll") for (int k = 0; k < 2; ++k) \
    acc[ai][bj][m][n] = __builtin_amdgcn_mfma_f32_16x16x32_bf16(Bt[n][k], At[m][k], acc[ai][bj][m][n], 0, 0, 0); __builtin_amdgcn_s_setprio(0); } while (0)
#define PG8_WAIT_V(n) asm volatile("s_waitcnt vmcnt(" #n ")" ::: "memory")
#define PG8_WAIT_L(n) asm volatile("s_waitcnt lgkmcnt(" #n ")" ::: "memory")
#define PG8_BAR __builtin_amdgcn_s_barrier()
#define PG8_SCHED __builtin_amdgcn_sched_barrier(0)
  Unit cur, nxt; int ui = 0;
  if (!S.next(0, cur)) return;
  f32x4 acc[2][2][4][2];
#pragma unroll
  for (int a = 0; a < 2; ++a)
#pragma unroll
    for (int b = 0; b < 2; ++b)
#pragma unroll
      for (int m = 0; m < 4; ++m)
#pragma unroll
        for (int n = 0; n < 2; ++n) acc[a][b][m][n] = (f32x4){0.f, 0.f, 0.f, 0.f};
  bf16x8 At[4][2], B0[2][2], B1[2][2];
  const char* cA = (const char*)g.A + (size_t)cur.pm * tstepA; const char* cB = (const char*)g.Bt + (size_t)cur.pn * tstepB;
  if constexpr (SP2) {
    PG8_STAGE(PG8_SB(0, 0), cB, voffB); PG8_STAGE(PG8_SB(0, 1), cB + hstepB, voffB); PG8_STAGE(PG8_SA(0, 0), cA, voffA); PG8_STAGE(PG8_SA(0, 1), cA + hstepA, voffA);
    if (wr == 1) PG8_BAR;
    PG8_WAIT_V(2); PG8_BAR;
    PG8_STAGE(PG8_SB(1, 0), cB + kstep, voffB); PG8_STAGE(PG8_SA(1, 0), cA + kstep, voffA); PG8_STAGE(PG8_SB(1, 1), cB + hstepB + kstep, voffB);
    PG8_WAIT_V(6); PG8_BAR;
  } else {
    PG8_STAGE(PG8_SB(0, 0), cB, voffB); PG8_STAGE(PG8_SA(0, 0), cA, voffA); PG8_STAGE(PG8_SB(0, 1), cB + hstepB, voffB); PG8_STAGE(PG8_SA(0, 1), cA + hstepA, voffA);
    if (wr == 1) PG8_BAR;
    PG8_WAIT_V(4); PG8_BAR;
    PG8_STAGE(PG8_SB(1, 0), cB + kstep, voffB); PG8_STAGE(PG8_SA(1, 0), cA + kstep, voffA); PG8_STAGE(PG8_SB(1, 1), cB + hstepB + kstep, voffB);
    PG8_WAIT_V(6); PG8_BAR;
  }
  for (;;) {
    const bool has_next = S.next(ui + 1, nxt);
    const char* nA = has_next ? (const char*)g.A + (size_t)nxt.pm * tstepA : cA; const char* nB = has_next ? (const char*)g.Bt + (size_t)nxt.pn * tstepB : cB;
    for (int t = 0; t < nt; t += 2) {
      const bool last = (t == nt - 2);
      const char* a1 = cA + (size_t)(t + 1) * kstep;
      const char* a2 = last ? nA : cA + (size_t)(t + 2) * kstep; const char* b2 = last ? nB : cB + (size_t)(t + 2) * kstep;
      const char* a3 = a2 + kstep; const char* b3 = b2 + kstep;
      if constexpr (SP2) {
        PG8_LDB(B0, 0, 0); PG8_LDB(B1, 0, 1); PG8_SCHED; PG8_LDA(At, 0, 0); PG8_STAGE(PG8_SA(1, 1), a1 + hstepA, voffA);
        PG8_WAIT_V(8); PG8_WAIT_L(0); PG8_BAR; PG8_MMA(0, 0, At, B0); PG8_MMA(0, 1, At, B1); PG8_BAR; PG8_SCHED;
        PG8_LDA(At, 0, 1); PG8_STAGE(PG8_SB(0, 0), b2, voffB); PG8_STAGE(PG8_SB(0, 1), b2 + hstepB, voffB); PG8_STAGE(PG8_SA(0, 0), a2, voffA);
        PG8_WAIT_V(8); PG8_WAIT_L(0); PG8_BAR; PG8_MMA(1, 0, At, B0); PG8_MMA(1, 1, At, B1); PG8_BAR; PG8_SCHED;
        PG8_LDB(B0, 1, 0); PG8_LDB(B1, 1, 1); PG8_SCHED; PG8_LDA(At, 1, 0); PG8_STAGE(PG8_SA(0, 1), a2 + hstepA, voffA);
        PG8_WAIT_V(8); PG8_WAIT_L(0); PG8_BAR; PG8_MMA(0, 0, At, B0); PG8_MMA(0, 1, At, B1); PG8_BAR; PG8_SCHED;
        PG8_LDA(At, 1, 1); PG8_STAGE(PG8_SB(1, 0), b3, voffB); PG8_STAGE(PG8_SB(1, 1), b3 + hstepB, voffB); PG8_STAGE(PG8_SA(1, 0), a3, voffA);
        PG8_WAIT_V(8); PG8_WAIT_L(0); PG8_BAR; PG8_MMA(1, 0, At, B0); PG8_MMA(1, 1, At, B1); PG8_BAR; PG8_SCHED;
      } else {
        PG8_LDB(B0, 0, 0); PG8_SCHED; PG8_LDA(At, 0, 0); PG8_STAGE(PG8_SA(1, 1), a1 + hstepA, voffA);
        PG8_WAIT_L(8); PG8_BAR; PG8_WAIT_L(0); PG8_MMA(0, 0, At, B0); PG8_BAR; PG8_SCHED;
        PG8_LDB(B1, 0, 1); PG8_STAGE(PG8_SB(0, 0), b2, voffB);
        PG8_BAR; PG8_WAIT_L(0); PG8_MMA(0, 1, At, B1); PG8_BAR;
        PG8_LDA(At, 0, 1); PG8_STAGE(PG8_SA(0, 0), a2, voffA);
        PG8_BAR; PG8_WAIT_L(0); PG8_MMA(1, 0, At, B0); PG8_BAR; PG8_SCHED;
        PG8_STAGE(PG8_SB(0, 1), b2 + hstepB, voffB);
        PG8_WAIT_V(6); PG8_BAR; PG8_MMA(1, 1, At, B1); PG8_BAR;
        PG8_LDB(B0, 1, 0); PG8_SCHED; PG8_LDA(At, 1, 0); PG8_STAGE(PG8_SA(0, 1), a2 + hstepA, voffA);
        PG8_WAIT_L(8); PG8_BAR; PG8_WAIT_L(0); PG8_MMA(0, 0, At, B0); PG8_BAR; PG8_SCHED;
        PG8_LDB(B1, 1, 1); PG8_STAGE(PG8_SB(1, 0), b3, voffB);
        PG8_BAR; PG8_WAIT_L(0); PG8_MMA(0, 1, At, B1); PG8_BAR;
        PG8_LDA(At, 1, 1); PG8_STAGE(PG8_SA(1, 0), a3, voffA);
        PG8_BAR; PG8_WAIT_L(0); PG8_MMA(1, 0, At, B0); PG8_BAR; PG8_SCHED;
        PG8_STAGE(PG8_SB(1, 1), b3 + hstepB, voffB);
        PG8_WAIT_V(6); PG8_BAR; PG8_MMA(1, 1, At, B1); PG8_BAR;
      }
    }
    if constexpr (ALIGN_EPI) { if (wr == 0) PG8_BAR; }
    { const int le = fresh_lane(); E(acc, cur, wr, wc, le & 15, le >> 4); }
    if (!has_next) break;
#pragma unroll
    for (int a = 0; a < 2; ++a)
#pragma unroll
      for (int b = 0; b < 2; ++b)
#pragma unroll
        for (int m = 0; m < 4; ++m)
#pragma unroll
          for (int n = 0; n < 2; ++n) acc[a][b][m][n] = (f32x4){0.f, 0.f, 0.f, 0.f};
    cur = nxt; cA = nA; cB = nB; ++ui;
    if constexpr (ALIGN_EPI) { if (wr == 1) PG8_BAR; }
  }
  PG8_WAIT_V(0);
  if constexpr (!ALIGN_EPI) { if (wr == 0) PG8_BAR; }
  PG8_BAR;
#undef PG8_SA
#undef PG8_SB
#undef PG8_STAGE
#undef PG8_LDA
#undef PG8_LDB
#undef PG8_MMA
#undef PG8_WAIT_V
#undef PG8_WAIT_L
#undef PG8_BAR
#undef PG8_SCHED
}

typedef f32x4 Acc[2][2][4][2];
struct EpiSwiglu { static constexpr bool PERM = true; bf16_t* O;
  __device__ __forceinline__ void operator()(const Acc& acc, const Unit& u, int wr, int wc, int fr, int fq) const {
    const int row0 = u.pm * BM + wr * 64 + fr, col0 = u.pn * 128 + wc * 32 + 8 * fq;
#pragma unroll
    for (int ai = 0; ai < 2; ++ai)
#pragma unroll
      for (int m = 0; m < 4; ++m) { bf16_t* p = O + (size_t)(row0 + ai * HALF + m * 16) * DFF + col0; f32x4 r[2];
#pragma unroll
        for (int n = 0; n < 2; ++n)
#pragma unroll
          for (int j = 0; j < 4; ++j) { const float gv = acc[ai][0][m][n][j], uv = acc[ai][1][m][n][j]; r[n][j] = gv * fast_sigmoid(gv) * uv; }
        *(u32x4*)p = pack8(r[0], r[1]); }
  }
};
struct EpiResid { static constexpr bool PERM = false; const float* base; float* out; const float* gvec; float coef;
  __device__ __forceinline__ void operator()(const Acc& acc, const Unit& u, int wr, int wc, int fr, int fq) const {
    const int row0 = u.pm * BM + wr * 64 + fr, col0 = u.pn * BM + wc * 32 + 4 * fq; const float* g = gvec + (size_t)(u.pm >> 5) * NADA;
    f32x4 gv[2][2];
#pragma unroll
    for (int bj = 0; bj < 2; ++bj)
#pragma unroll
      for (int n = 0; n < 2; ++n) gv[bj][n] = *(const f32x4*)(g + col0 + bj * HALF + n * 16) * coef;
#pragma unroll
    for (int ai = 0; ai < 2; ++ai)
#pragma unroll
      for (int m = 0; m < 4; ++m) { const size_t off = (size_t)(row0 + ai * HALF + m * 16) * DM + col0;
#pragma unroll
        for (int bj = 0; bj < 2; ++bj)
#pragma unroll
          for (int n = 0; n < 2; ++n) { const f32x4 b = *(const f32x4*)(base + off + bj * HALF + n * 16); *(f32x4*)(out + off + bj * HALF + n * 16) = b + gv[bj][n] * acc[ai][bj][m][n]; } }
  }
};
struct EpiWin { static constexpr bool PERM = true; bf16_t *V, *GATES, *ZL, *KR; float *rsq_q, *rsq_kv; const float* rope;
  __device__ __forceinline__ void operator()(const Acc& acc, const Unit& u, int wr, int wc, int fr, int fq) const {
    const int row0 = u.pm * BM + wr * 64 + fr, cw = wc * 32 + 8 * fq;
    if (u.pn < 4) {
#pragma unroll
      for (int ai = 0; ai < 2; ++ai)
#pragma unroll
        for (int m = 0; m < 4; ++m)
#pragma unroll
          for (int bj = 0; bj < 2; ++bj) *(u32x4*)(V + (size_t)(row0 + ai * HALF + m * 16) * 1024 + u.pn * 256 + bj * HALF + cw) = pack8(acc[ai][bj][m][0], acc[ai][bj][m][1]);
    } else if (u.pn < 12) {
#pragma unroll
      for (int ai = 0; ai < 2; ++ai)
#pragma unroll
        for (int m = 0; m < 4; ++m)
#pragma unroll
          for (int bj = 0; bj < 2; ++bj) { f32x4 a = acc[ai][bj][m][0], b = acc[ai][bj][m][1];
#pragma unroll
            for (int j = 0; j < 4; ++j) { a[j] = fast_sigmoid(a[j]); b[j] = fast_sigmoid(b[j]); }
            *(u32x4*)(GATES + (size_t)(row0 + ai * HALF + m * 16) * 2048 + (u.pn - 4) * 256 + bj * HALF + cw) = pack8(a, b); }
    } else {
#pragma unroll
      for (int bj = 0; bj < 2; ++bj) { const int zc0 = (u.pn - 12) * 256 + bj * HALF;
        if (zc0 < 640) { float* rsq = zc0 < 384 ? rsq_q : rsq_kv;
#pragma unroll
          for (int ai = 0; ai < 2; ++ai)
#pragma unroll
            for (int m = 0; m < 4; ++m) { const int row = row0 + ai * HALF + m * 16; const f32x4 a = acc[ai][bj][m][0], b = acc[ai][bj][m][1];
              *(u32x4*)(ZL + (size_t)row * ZLW + zc0 + cw) = pack8(a, b);
              float ss = (a[0] * a[0] + a[1] * a[1]) + (a[2] * a[2] + a[3] * a[3]) + (b[0] * b[0] + b[1] * b[1]) + (b[2] * b[2] + b[3] * b[3]);
              ss += __shfl_xor(ss, 16); ss += __shfl_xor(ss, 32);
              if (fq == 0) __hip_atomic_fetch_add(rsq + row, ss, __ATOMIC_RELAXED, __HIP_MEMORY_SCOPE_AGENT); }
        } else if (wc == 0) {
#pragma unroll
          for (int ai = 0; ai < 2; ++ai)
#pragma unroll
            for (int m = 0; m < 4; ++m) { const int row = row0 + ai * HALF + m * 16; const f32x4 a = acc[ai][bj][m][0], b = acc[ai][bj][m][1];
              const f32x4 cs = *(const f32x4*)(rope + (size_t)row * 32 + 4 * fq), sn = *(const f32x4*)(rope + (size_t)row * 32 + 16 + 4 * fq);
              f32x4 oa, ob;
              oa[0] = a[0] * cs[0] - a[1] * sn[0]; oa[1] = a[1] * cs[0] + a[0] * sn[0]; oa[2] = a[2] * cs[1] - a[3] * sn[1]; oa[3] = a[3] * cs[1] + a[2] * sn[1];
              ob[0] = b[0] * cs[2] - b[1] * sn[2]; ob[1] = b[1] * cs[2] + b[0] * sn[2]; ob[2] = b[2] * cs[3] - b[3] * sn[3]; ob[3] = b[3] * cs[3] + b[2] * sn[3];
              *(u32x4*)(KR + (size_t)row * 32 + 8 * fq) = pack8(oa, ob); }
        }
      }
    }
  }
};
struct EpiQ { static constexpr bool PERM = true; bf16_t* Q; const float* rsq; const float* rope;
  __device__ __forceinline__ void operator()(const Acc& acc, const Unit& u, int wr, int wc, int fr, int fq) const {
    const int row0 = u.pm * BM + wr * 64 + fr;
#pragma unroll
    for (int ai = 0; ai < 2; ++ai)
#pragma unroll
      for (int m = 0; m < 4; ++m) { const unsigned row = (unsigned)(row0 + ai * HALF + m * 16); const float rs = rsqrtf(rsq[row] * (1.0f / QLR) + NORM_EPS);
#pragma unroll
        for (int bj = 0; bj < 2; ++bj) { const unsigned c0 = (unsigned)(u.pn * BM + bj * HALF + wc * 32 + 8 * fq), d = c0 % 96u;
          f32x4 a = acc[ai][bj][m][0] * rs, b = acc[ai][bj][m][1] * rs;
          if (d >= 64u) { const unsigned j0 = (d - 64u) >> 1; const f32x4 cs = *(const f32x4*)(rope + (row * 32u + j0)), sn = *(const f32x4*)(rope + (row * 32u + 16u + j0));
            f32x4 oa, ob;
            oa[0] = a[0] * cs[0] - a[1] * sn[0]; oa[1] = a[1] * cs[0] + a[0] * sn[0]; oa[2] = a[2] * cs[1] - a[3] * sn[1]; oa[3] = a[3] * cs[1] + a[2] * sn[1];
            ob[0] = b[0] * cs[2] - b[1] * sn[2]; ob[1] = b[1] * cs[2] + b[0] * sn[2]; ob[2] = b[2] * cs[3] - b[3] * sn[3]; ob[3] = b[3] * cs[3] + b[2] * sn[3];
            a = oa; b = ob; }
          *(u32x4*)(Q + (row * (unsigned)NQ + c0)) = pack8(a, b);
          asm volatile("" ::: "memory"); } }
  }
};
struct EpiKV { static constexpr bool PERM = true; bf16_t* KV; const float* rsq;
  __device__ __forceinline__ void operator()(const Acc& acc, const Unit& u, int wr, int wc, int fr, int fq) const {
    const int row0 = u.pm * BM + wr * 64 + fr;
#pragma unroll
    for (int ai = 0; ai < 2; ++ai)
#pragma unroll
      for (int m = 0; m < 4; ++m) { const int row = row0 + ai * HALF + m * 16; const float rs = rsqrtf(rsq[row] * (1.0f / KVLR) + NORM_EPS);
#pragma unroll
        for (int bj = 0; bj < 2; ++bj) { const int c0 = u.pn * BM + bj * HALF + wc * 32 + 8 * fq;
          *(u32x4*)(KV + (size_t)row * NKV + c0) = pack8(acc[ai][bj][m][0] * rs, acc[ai][bj][m][1] * rs); } }
  }
};
template <bool ADD, int GOFF> struct EpiMerge { static constexpr bool PERM = true; bf16_t* YM; const bf16_t* G;
  __device__ __forceinline__ void operator()(const Acc& acc, const Unit& u, int wr, int wc, int fr, int fq) const {
    const int row0 = u.pm * BM + wr * 64 + fr;
#pragma unroll
    for (int ai = 0; ai < 2; ++ai)
#pragma unroll
      for (int m = 0; m < 4; ++m) { const int row = row0 + ai * HALF + m * 16;
#pragma unroll
        for (int bj = 0; bj < 2; ++bj) { const int c0 = u.pn * BM + bj * HALF + wc * 32 + 8 * fq;
          const u32x4 gw = *(const u32x4*)(G + (size_t)row * 2048 + GOFF + c0);
          f32x4 a = acc[ai][bj][m][0], b = acc[ai][bj][m][1];
#ifndef DBG_NOGATE
          a[0] *= bf_lo(gw.x); a[1] *= bf_hi(gw.x); a[2] *= bf_lo(gw.y); a[3] *= bf_hi(gw.y); b[0] *= bf_lo(gw.z); b[1] *= bf_hi(gw.z); b[2] *= bf_lo(gw.w); b[3] *= bf_hi(gw.w);
#else
          a[0] += 1e-30f * bf_lo(gw.x);
#endif
          bf16_t* p = YM + (size_t)row * DM + c0;
          if (ADD) { const u32x4 t = *(const u32x4*)p;
            a[0] += bf_lo(t.x); a[1] += bf_hi(t.x); a[2] += bf_lo(t.y); a[3] += bf_hi(t.y); b[0] += bf_lo(t.z); b[1] += bf_hi(t.z); b[2] += bf_lo(t.w); b[3] += bf_hi(t.w); }
          *(u32x4*)p = pack8(a, b); } }
  }
};
}

namespace attn {
constexpr int SHM_V = 64 * 64 * 2, SHM_K = 64 * 256, LDS_BYTES = 2 * SHM_V + 2 * SHM_K + 8 * 64 * 4;
constexpr float THRL = 11.5f;
#define KSWZ(row, colB) ((row) * 256 + ((colB) ^ (((row) & 7) << 4)))
__device__ __forceinline__ int crow(int r, int hi) { return (r & 3) + 8 * (r >> 2) + 4 * hi; }
typedef short v4i16_t __attribute__((ext_vector_type(4)));
__device__ __forceinline__ s16x4 vtr(const LAS unsigned char* p) { return __builtin_bit_cast(s16x4, __builtin_amdgcn_ds_read_tr16_b64_v4i16((LAS v4i16_t*)p)); }
__device__ __forceinline__ int swap23(int k) { return (k & ~0xC) | ((k & 4) << 1) | ((k & 8) >> 1); }
__device__ __forceinline__ int v_rd_base(int lane) { return ((lane & 3) << 3) | (((lane >> 2) & 3) << 6) | (((lane >> 4) & 1) << 5) | (((lane >> 5) & 1) << 8); }
template <int NB> __device__ __forceinline__ int t_st(int k, int n) { const int kk = swap23(k); return ((kk >> 3) * NB + (n >> 5)) * 512 + ((kk & 7) * 32 + (n & 31)) * 2; }
template <int NB> __device__ __forceinline__ bf16x8 t_frag(const LAS unsigned char* base, int ks, int nb) {
  const s16x4 l = vtr(base + nb * 512 + ks * (1024 * NB)), h = vtr(base + nb * 512 + ks * (1024 * NB) + 512 * NB);
  return (bf16x8){l[0], l[1], l[2], l[3], h[0], h[1], h[2], h[3]};
}
template <int NB> __device__ __forceinline__ int t_stn(int k, int n) { return ((k >> 3) * NB + (n >> 5)) * 512 + ((k & 7) * 32 + (n & 31)) * 2; }
template <bool FIRST> __device__ __forceinline__ float partialSM(f32x16& p0, f32x16& p1, float& mhat, f32x16& negm) {
  float a = fmaxf(fmaxf(p0[0], p0[1]), p0[2]), b = fmaxf(fmaxf(p1[0], p1[1]), p1[2]);
#pragma unroll
  for (int r = 3; r < 15; r += 2) { a = fmaxf(fmaxf(a, p0[r]), p0[r + 1]); b = fmaxf(fmaxf(b, p1[r]), p1[r + 1]); }
  float pmax = fmaxf(fmaxf(a, b), fmaxf(p0[15], p1[15]));
  { auto rr = __builtin_amdgcn_permlane32_swap(__float_as_uint(pmax), __float_as_uint(pmax), false, false);
    pmax = fmaxf(__uint_as_float(rr[0]), __uint_as_float(rr[1])); }
  float alpha = 1.f;
  if (FIRST || !__builtin_expect(__all(pmax <= THRL), 1)) {
    const float dl = FIRST ? pmax : fmaxf(pmax, 0.f);
    mhat += dl;
#pragma unroll
    for (int r = 0; r < 16; ++r) { p0[r] -= dl; p1[r] -= dl; negm[r] = -mhat; }
    if (!FIRST) alpha = __builtin_amdgcn_exp2f(-dl);
  }
#pragma unroll
  for (int r = 0; r < 16; ++r) p0[r] = __builtin_amdgcn_exp2f(p0[r]);
  return alpha;
}
__device__ __forceinline__ void finishSM(f32x16& p0, f32x16& p1, bf16x8& pa0, bf16x8& pa1, bf16x8& pa2, bf16x8& pa3) {
#pragma unroll
  for (int r = 0; r < 16; ++r) p1[r] = __builtin_amdgcn_exp2f(p1[r]);
#define PK8(P, BASE, OUT) do { u32x4 w = {cvt_pk_bf16(P[BASE + 0], P[BASE + 1]), cvt_pk_bf16(P[BASE + 2], P[BASE + 3]), cvt_pk_bf16(P[BASE + 4], P[BASE + 5]), cvt_pk_bf16(P[BASE + 6], P[BASE + 7])}; \
    OUT = __builtin_bit_cast(bf16x8, w); } while (0)
  PK8(p0, 0, pa0); PK8(p0, 8, pa1); PK8(p1, 0, pa2); PK8(p1, 8, pa3);
#undef PK8
}
__device__ __forceinline__ void qkt(f32x16& p0, f32x16& p1, const LAS unsigned char* Ks, const bf16x8* qr, const f32x16& negm, int r32, int hi) {
#pragma unroll
  for (int d0 = 0; d0 < 6; ++d0) { const int cb = (d0 * 16 + hi * 8) * 2;
    const bf16x8 b0 = *(const LAS bf16x8*)(Ks + KSWZ(r32, cb));
    const bf16x8 b1 = *(const LAS bf16x8*)(Ks + KSWZ(32 + r32, cb));
    if (d0 == 0) { p0 = __builtin_amdgcn_mfma_f32_32x32x16_bf16(b0, qr[0], negm, 0, 0, 0); p1 = __builtin_amdgcn_mfma_f32_32x32x16_bf16(b1, qr[0], negm, 0, 0, 0); }
    else { p0 = __builtin_amdgcn_mfma_f32_32x32x16_bf16(b0, qr[d0], p0, 0, 0, 0); p1 = __builtin_amdgcn_mfma_f32_32x32x16_bf16(b1, qr[d0], p1, 0, 0, 0); } }
}
__device__ __forceinline__ void pv2(f32x16* o, f32x16& ol, const LAS unsigned char* vb, bf16x8 pa0, bf16x8 pa1, bf16x8 pa2, bf16x8 pa3) {
  const bf16x8 ones = {0x3F80, 0x3F80, 0x3F80, 0x3F80, 0x3F80, 0x3F80, 0x3F80, 0x3F80};
#pragma unroll
  for (int d0 = 0; d0 < 2; ++d0) {
    const bf16x8 v0 = t_frag<2>(vb, 0, d0), v1 = t_frag<2>(vb, 1, d0), v2 = t_frag<2>(vb, 2, d0), v3 = t_frag<2>(vb, 3, d0);
    o[d0] = __builtin_amdgcn_mfma_f32_32x32x16_bf16(pa0, v0, o[d0], 0, 0, 0);
    o[d0] = __builtin_amdgcn_mfma_f32_32x32x16_bf16(pa1, v1, o[d0], 0, 0, 0);
    o[d0] = __builtin_amdgcn_mfma_f32_32x32x16_bf16(pa2, v2, o[d0], 0, 0, 0);
    o[d0] = __builtin_amdgcn_mfma_f32_32x32x16_bf16(pa3, v3, o[d0], 0, 0, 0);
  }
  ol = __builtin_amdgcn_mfma_f32_32x32x16_bf16(pa0, ones, ol, 0, 0, 0);
  ol = __builtin_amdgcn_mfma_f32_32x32x16_bf16(pa1, ones, ol, 0, 0, 0);
  ol = __builtin_amdgcn_mfma_f32_32x32x16_bf16(pa2, ones, ol, 0, 0, 0);
  ol = __builtin_amdgcn_mfma_f32_32x32x16_bf16(pa3, ones, ol, 0, 0, 0);
}
__device__ __forceinline__ unsigned f2bf(float f) { unsigned u = __float_as_uint(f); return (u + 0x7fffu + ((u >> 16) & 1u)) >> 16; }

__device__ __forceinline__ void attn_unit(int b, int h, int qb, const bf16_t* Q, const bf16_t* KV, const bf16_t* KR, bf16_t* O, LAS unsigned char* lds, const int wid) {
  const int lane = fresh_lane(), tid = wid * 64 + lane, r32 = lane & 31, hi = lane >> 5;
  LAS unsigned char* V_lds = lds; LAS unsigned char* K_lds = lds + 2 * SHM_V;
  LAS float* ws = (LAS float*)(lds + 2 * SHM_V + 2 * SHM_K) + wid * 64; LAS float* li_l = ws; LAS float* al_l = ws + 32;
  float mhat = 0.f; f32x16 o[2] = {}; f32x16 ol = {}; f32x16 negm = {}; bf16x8 qr[6];
  const size_t tok0 = (size_t)b * SEQ;
  const bf16_t* Qw = Q + (tok0 + qb * 256 + wid * 32 + r32) * NQ + h * 96 + hi * 8;
#pragma unroll
  for (int d0 = 0; d0 < 6; ++d0) qr[d0] = *(const bf16x8*)(Qw + d0 * 16);
  const int srow = tid >> 3, sch = tid & 7;
  const bf16_t* kp = KV + (tok0 + srow) * NKV + h * 128 + sch * 8; const bf16_t* vp = kp + 64; const bf16_t* rp = KR + (tok0 + srow) * 32 + sch * 4;
  const int kst = KSWZ(srow, sch * 16), vst = t_stn<2>(srow, sch * 8), rst = KSWZ(srow, 128 + (sch >> 1) * 16) + (sch & 1) * 8;
  const LAS unsigned char* vb0 = V_lds + v_rd_base(lane);
  bf16x8 ksA, vsA, ksB, vsB; u32x2 rsA, rsB;
#define SLOAD(S, k0) do { ks##S = *(const bf16x8*)(kp + (size_t)(k0) * NKV); vs##S = *(const bf16x8*)(vp + (size_t)(k0) * NKV); rs##S = *(const u32x2*)(rp + (size_t)(k0) * 32); } while (0)
#define SWRITE(bf, S) do { *(LAS bf16x8*)(K_lds + (bf) * SHM_K + kst) = ks##S; *(LAS bf16x8*)(V_lds + (bf) * SHM_V + vst) = vs##S; *(LAS u32x2*)(K_lds + (bf) * SHM_K + rst) = rs##S; } while (0)
#define SWAIT() asm volatile("s_waitcnt vmcnt(3)" ::: "memory")
#define RESC(a) do { if (__any((a) != 1.f)) { if (hi == 0) al_l[r32] = (a); LDS_WAIT(); \
    _Pragma("unroll") for (int r = 0; r < 16; ++r) { const float f_ = al_l[crow(r, hi)]; o[0][r] *= f_; o[1][r] *= f_; ol[r] *= f_; } } } while (0)
#define SBAR() __builtin_amdgcn_sched_barrier(0)
  f32x16 pA0, pA1, pB0, pB1; float alA, alB; bf16x8 pa0, pa1, pa2, pa3; constexpr int NT = SEQ / 64;
  SLOAD(A, 0); VM_WAIT(); SWRITE(0, A); __syncthreads();
  qkt(pA0, pA1, K_lds, qr, negm, r32, hi); alA = partialSM<true>(pA0, pA1, mhat, negm);
  SLOAD(B, 64); SLOAD(A, 128);
  SWAIT(); SWRITE(1, B); __syncthreads();
  for (int j = 1; j + 1 < NT; j += 2) {
    SBAR(); qkt(pB0, pB1, K_lds + SHM_K, qr, negm, r32, hi);
    finishSM(pA0, pA1, pa0, pa1, pa2, pa3); SBAR();
    SLOAD(B, (j + 2) * 64); SBAR();
    pv2(o, ol, vb0, pa0, pa1, pa2, pa3); alB = partialSM<false>(pB0, pB1, mhat, negm);
    __syncthreads(); SWAIT(); SWRITE(0, A);
    RESC(alB); __syncthreads();
    SBAR(); qkt(pA0, pA1, K_lds, qr, negm, r32, hi);
    finishSM(pB0, pB1, pa0, pa1, pa2, pa3); SBAR();
    if (j + 3 < NT) SLOAD(A, (j + 3) * 64); SBAR();
    pv2(o, ol, vb0 + SHM_V, pa0, pa1, pa2, pa3); alA = partialSM<false>(pA0, pA1, mhat, negm);
    __syncthreads(); SWAIT(); SWRITE(1, B);
    RESC(alA); __syncthreads();
  }
  SBAR(); qkt(pB0, pB1, K_lds + SHM_K, qr, negm, r32, hi);
  finishSM(pA0, pA1, pa0, pa1, pa2, pa3); SBAR();
  pv2(o, ol, vb0, pa0, pa1, pa2, pa3); alB = partialSM<false>(pB0, pB1, mhat, negm);
  __syncthreads(); RESC(alB);
  finishSM(pB0, pB1, pa0, pa1, pa2, pa3); SBAR();
  pv2(o, ol, vb0 + SHM_V, pa0, pa1, pa2, pa3);
  float rli[16];
#pragma unroll
  for (int r = 0; r < 16; ++r) rli[r] = __builtin_amdgcn_rcpf(ol[r]);
  bf16_t* Ow = O + (tok0 + qb * 256 + wid * 32) * 512 + h * 64;
#pragma unroll
  for (int r = 0; r < 16; ++r) { const int orow = crow(r, hi);
#pragma unroll
    for (int d0 = 0; d0 < 2; ++d0) Ow[(size_t)orow * 512 + d0 * 32 + r32] = (bf16_t)f2bf(o[d0][r] * rli[r]); }
  VM_WAIT(); __syncthreads();
#undef SLOAD
#undef SWRITE
#undef SWAIT
#undef RESC
#undef SBAR
}
}

namespace fft {
using attn::crow; using attn::t_st; using attn::t_frag; using attn::v_rd_base; using attn::f2bf;
__device__ __forceinline__ int am64(int row, int k) { return row * 128 + ((((k >> 3) ^ (row & 7))) << 4) + (k & 7) * 2; }
__device__ __forceinline__ int am128(int row, int k) { return row * 256 + ((((k >> 3) ^ (row & 15))) << 4) + (k & 7) * 2; }
constexpr int T_OFF = 0, A_OFF = 65536, TWL_OFF = 65536 + 24576;
__device__ __forceinline__ void stage1(const bf16_t* V, bf16_t* Y, const bf16_t* c64  , const float* tw, LAS unsigned char* lds, int first, int stride, const int wid) {
  const int lane = fresh_lane(), tid = wid * 64 + lane, r32 = lane & 31, hi = lane >> 5;
  LAS unsigned char* T = lds + T_OFF; LAS unsigned char* A = lds + A_OFF; LAS f32x2* twl = (LAS f32x2*)(lds + TWL_OFF);
#pragma unroll
  for (int i = 0; i < 3; ++i) { const int idx = tid + 512 * i, mi = idx >> 9, ch = idx & 511, row = ch >> 3, kc = ch & 7;
    *(LAS u32x4*)(A + mi * 8192 + am64(row, kc * 8)) = *(const u32x4*)(c64 + mi * 4096 + row * 64 + kc * 8); }
  u32x4 st[8];
#define F1_LOAD(u) do { const int b_ = (u) >> 8, b2_ = ((u) >> 1) & 127, hf_ = (u) & 1; \
    _Pragma("unroll") for (int i = 0; i < 8; ++i) { const int idx = tid + 512 * i, a = idx >> 6, n = (idx & 63) * 8; const int gcol = (n < 256) ? hf_ * 256 + n : 512 + hf_ * 256 + (n - 256); \
      st[i] = *(const u32x4*)(V + ((size_t)b_ * SEQ + 128 * a + b2_) * 1024 + gcol); } } while (0)
  int u = first; if (u >= 1024) return;
  F1_LOAD(u);
  for (;;) {
    const int b = u >> 8, b2 = (u >> 1) & 127, hf = u & 1;
#pragma unroll
    for (int i = 0; i < 8; ++i) { const int idx = tid + 512 * i, a = idx >> 6, n = (idx & 63) * 8; *(LAS u32x4*)(T + t_st<16>(a, n)) = st[i]; }
    if (tid < 64) twl[tid] = *(const f32x2*)(tw + ((size_t)tid * 128 + b2) * 2);
    __syncthreads();
    const int un = u + stride; if (un < 1024) F1_LOAD(un);
    const LAS unsigned char* tb = T + v_rd_base(lane);
    {
      asm volatile("" ::: "memory");
      const int nbr = wid, nbi = 8 + wid;
      f32x16 ar[2] = {}, ai[2] = {};
#pragma unroll
      for (int ks = 0; ks < 4; ++ks) {
        const bf16x8 Br = t_frag<16>(tb, ks, nbr), Bi = t_frag<16>(tb, ks, nbi);
#pragma unroll
        for (int mb = 0; mb < 2; ++mb) { const int off = am64(32 * mb + r32, 16 * ks + 8 * hi);
          const bf16x8 Ac = *(const LAS bf16x8*)(A + off), As = *(const LAS bf16x8*)(A + 8192 + off), An = *(const LAS bf16x8*)(A + 16384 + off);
          ar[mb] = __builtin_amdgcn_mfma_f32_32x32x16_bf16(Ac, Br, ar[mb], 0, 0, 0); ar[mb] = __builtin_amdgcn_mfma_f32_32x32x16_bf16(As, Bi, ar[mb], 0, 0, 0);
          ai[mb] = __builtin_amdgcn_mfma_f32_32x32x16_bf16(Ac, Bi, ai[mb], 0, 0, 0); ai[mb] = __builtin_amdgcn_mfma_f32_32x32x16_bf16(An, Br, ai[mb], 0, 0, 0); }
      }
      const int colr = hf * 256 + 32 * wid + r32;
#pragma unroll
      for (int mb = 0; mb < 2; ++mb)
#pragma unroll
        for (int r = 0; r < 16; ++r) { const int c = 32 * mb + crow(r, hi); const f32x2 t = twl[c]; const float yr = ar[mb][r], yi = ai[mb][r];
          bf16_t* dst = Y + (((size_t)b * 64 + c) * 128 + b2) * 1024 + colr;
          dst[0] = (bf16_t)f2bf(yr * t.x + yi * t.y); dst[512] = (bf16_t)f2bf(yi * t.x - yr * t.y); }
    }
    __syncthreads();
    if (un >= 1024) break; u = un;
  }
#undef F1_LOAD
}
__device__ __forceinline__ void stage2(const bf16_t* Y, bf16_t* F, const bf16_t* c128  , LAS unsigned char* lds, int first, int stride, const int wid) {
  const int lane = fresh_lane(), tid = wid * 64 + lane, r32 = lane & 31, hi = lane >> 5;
  LAS unsigned char* T = lds + T_OFF; LAS unsigned char* A = lds + A_OFF;
#pragma unroll
  for (int i = 0; i < 8; ++i) { const int idx = tid + 512 * i, mi = idx >> 11, ch = idx & 2047, row = ch >> 4, kc = ch & 15;
    *(LAS u32x4*)(A + mi * 32768 + am128(row, kc * 8)) = *(const u32x4*)(c128 + mi * 16384 + row * 128 + kc * 8); }
  u32x4 st[8];
#define F2_LOAD(u) do { const int b_ = (u) >> 8, c_ = ((u) >> 2) & 63, qt_ = (u) & 3; \
    _Pragma("unroll") for (int i = 0; i < 8; ++i) { const int idx = tid + 512 * i, row = idx >> 5, n = (idx & 31) * 8; const int gcol = (n < 128) ? qt_ * 128 + n : 512 + qt_ * 128 + (n - 128); \
      st[i] = *(const u32x4*)(Y + (((size_t)b_ * 64 + c_) * 128 + row) * 1024 + gcol); } } while (0)
  int u = first; if (u >= 1024) return;
  F2_LOAD(u);
  for (;;) {
    const int b = u >> 8, c = (u >> 2) & 63, qt = u & 3;
#pragma unroll
    for (int i = 0; i < 8; ++i) { const int idx = tid + 512 * i, row = idx >> 5, n = (idx & 31) * 8; *(LAS u32x4*)(T + t_st<8>(row, n)) = st[i]; }
    __syncthreads();
    const int un = u + stride; if (un < 1024) F2_LOAD(un);
    const LAS unsigned char* tb = T + v_rd_base(lane);
    const int nb = wid & 3, mh = wid >> 2;
    asm volatile("" ::: "memory");
    f32x16 acc[2] = {};
#pragma unroll
    for (int ks = 0; ks < 8; ++ks) {
      const bf16x8 Br = t_frag<8>(tb, ks, nb), Bi = t_frag<8>(tb, ks, 4 + nb);
#pragma unroll
      for (int mb = 0; mb < 2; ++mb) { const int off = am128(64 * mh + 32 * mb + r32, 16 * ks + 8 * hi);
        const bf16x8 Ac = *(const LAS bf16x8*)(A + off), As = *(const LAS bf16x8*)(A + 32768 + off);
        acc[mb] = __builtin_amdgcn_mfma_f32_32x32x16_bf16(Ac, Br, acc[mb], 0, 0, 0); acc[mb] = __builtin_amdgcn_mfma_f32_32x32x16_bf16(As, Bi, acc[mb], 0, 0, 0); }
    }
#pragma unroll
    for (int mb = 0; mb < 2; ++mb)
#pragma unroll
      for (int r = 0; r < 16; ++r) { const int d = 64 * mh + 32 * mb + crow(r, hi);
        F[((size_t)b * SEQ + c + 64 * d) * 512 + qt * 128 + 32 * nb + r32] = (bf16_t)f2bf(acc[mb][r]); }
    __syncthreads();
    if (un >= 1024) break; u = un;
  }
#undef F2_LOAD
}
}

#define XB_TMO      128
#define XB_XCNT(j)  (256  + 64 * (j))
#define XB_XSUB(j)  (1280 + 64 * (j))
#define XB_XGEN(j)  (2304 + 64 * (j))
#define XB_TOP      3328
#define XB_TOPGEN   3392
#define XCD_BAR_WORDS 3456
#define XB_SPIN_CAP (1u << 18)
__device__ __forceinline__ unsigned xb_ld(unsigned* p)              { return __hip_atomic_load(p, __ATOMIC_RELAXED, __HIP_MEMORY_SCOPE_AGENT); }
__device__ __forceinline__ unsigned xb_add(unsigned* p, unsigned v) { return __hip_atomic_fetch_add(p, v, __ATOMIC_RELAXED, __HIP_MEMORY_SCOPE_AGENT); }
__device__ __forceinline__ unsigned xb_xcc_id() { return (unsigned)__builtin_amdgcn_s_getreg((3 << 11) | 20) & 0xFu; }
#define XB_SPIN(cond, bar) do { unsigned _sp = 0; while (cond) { __builtin_amdgcn_s_sleep(1); \
    if ((++_sp & 255u) == 0u) { if (xb_ld(&(bar)[XB_TMO])) break; if (_sp > XB_SPIN_CAP) { atomicAdd(&(bar)[XB_TMO], 1u); break; } } } } while (0)
struct XcdBarrier { unsigned* bar; unsigned x; volatile LAS unsigned* st; };
__device__ __forceinline__ XcdBarrier xcd_barrier_post(unsigned* bar, volatile LAS unsigned* st) {
  XcdBarrier b; b.bar = bar; b.x = xb_xcc_id(); b.st = st;
  if (threadIdx.x == 0) (void)xb_add(&bar[XB_XCNT(b.x)], 1u);
  return b;
}
__device__ __forceinline__ void xcd_barrier_complete(unsigned* bar, unsigned x, unsigned& nloc, unsigned& nx) {
  const unsigned G = gridDim.x * gridDim.y * gridDim.z;
  unsigned sum, cnt, mine, sp = 0u;
  for (;;) {
    sum = 0u; cnt = 0u; mine = 0u;
#pragma unroll
    for (unsigned j = 0; j < 16; ++j) { const unsigned c = xb_ld(&bar[XB_XCNT(j)]); sum += c; cnt += (c > 0u) ? 1u : 0u; mine = (j == x) ? c : mine; }
    if (sum == G) break;
    __builtin_amdgcn_s_sleep(1);
    if ((++sp & 255u) == 0u) { if (xb_ld(&bar[XB_TMO])) break; if (sp > XB_SPIN_CAP) { atomicAdd(&bar[XB_TMO], 1u); break; } }
  }
  nloc = mine > 0u ? mine : 1u; nx = cnt > 0u ? cnt : 1u;
}
__device__ __forceinline__ void xcd_barrier(const XcdBarrier& b) {
  asm volatile("s_waitcnt vmcnt(0)" ::: "memory");
  __syncthreads();
  if (threadIdx.x == 0) {
    unsigned* bar = b.bar;
    __builtin_amdgcn_s_waitcnt(0);
    unsigned nloc = b.st[0], nx = b.st[1];
    if (nloc == 0u) { xcd_barrier_complete(bar, b.x, nloc, nx); b.st[0] = nloc; b.st[1] = nx; }
    const unsigned old = xb_add(&bar[XB_XSUB(b.x)], 1u);
    const unsigned gen = old / nloc;
    if (old + 1u == (gen + 1u) * nloc) {
      __builtin_amdgcn_fence(__ATOMIC_RELEASE, "agent");
      asm volatile("s_waitcnt vmcnt(0)" ::: "memory");
      const unsigned og = xb_add(&bar[XB_TOP], 1u);
      const unsigned tg = og / nx;
      if (og + 1u == (tg + 1u) * nx) xb_add(&bar[XB_TOPGEN], 1u);
      else XB_SPIN(xb_ld(&bar[XB_TOPGEN]) == tg, bar);
      __builtin_amdgcn_fence(__ATOMIC_ACQUIRE, "agent");
      xb_add(&bar[XB_XGEN(b.x)], 1u);
      asm volatile("s_waitcnt vmcnt(0)" ::: "memory");
    } else {
      XB_SPIN(xb_ld(&bar[XB_XGEN(b.x)]) == gen, bar);
      __builtin_amdgcn_fence(__ATOMIC_ACQUIRE, "agent");
      asm volatile("s_waitcnt vmcnt(0)" ::: "memory");
    }
  }
  __syncthreads();
}

constexpr int NWAVES = 8;
constexpr int RING_BYTES = 131072, LDSCTL_OFF = RING_BYTES, MISC_OFF = LDSCTL_OFF + 320, FOLD_OFF = RING_BYTES + 1024;
constexpr int LDS_BYTES = 147456;
struct Args { const float* in[23]; float* out; unsigned char* ws; int ph_lo, ph_hi; };
struct Frame {
  LAS unsigned char* lds; int wave, vcu, G;
  const float* const* in; float* out; unsigned char* ws;
};

__device__ __forceinline__ void p0_transpose_item(const float* W, int ldw, int k0, int n0, bf16_t* WT, int ldwt, int drow0, bool perm, const float* kscale, float cscale, LAS float* scr, int lane) {
#pragma unroll 8
  for (int i = 0; i < 32; ++i) { const int kk = 2 * i + (lane >> 5); float v = W[(size_t)(k0 + kk) * ldw + n0 + (lane & 31)]; if (kscale) v *= kscale[k0 + kk]; scr[kk * 33 + (lane & 31)] = v * cscale; }
  LDS_WAIT(); asm volatile("" ::: "memory");
  const int c = lane & 7;
#pragma unroll
  for (int j = 0; j < 4; ++j) { const int n = (lane >> 3) + 8 * j; const LAS float* s = scr + (8 * c) * 33 + n;
    u32x4 o; o.x = cvt_pk_bf16(s[0 * 33], s[1 * 33]); o.y = cvt_pk_bf16(s[2 * 33], s[3 * 33]); o.z = cvt_pk_bf16(s[4 * 33], s[5 * 33]); o.w = cvt_pk_bf16(s[6 * 33], s[7 * 33]);
    const int dr = drow0 + (perm ? (n < 16 ? 2 * n : 2 * (n - 16) + 1) : n);
    *(u32x4*)(WT + (size_t)dr * ldwt + k0 + 8 * c) = o; }
  LDS_WAIT(); asm volatile("" ::: "memory");
}
constexpr int I_GU = 16 * 88, I_DN = 44 * 32, I_WIN = 16 * 85, I_WQ = 6 * 24, I_WKV = 4 * 32, I_WF = 8 * 32, I_WO = 16 * 32;
constexpr int NTRANS = 4 * I_GU + 2 * I_DN + I_WIN + I_WQ + I_WKV + 2 * I_WF + I_WO;
constexpr int NMODI = 144 * 32;
__device__ __forceinline__ void p0_trans_dispatch(const Frame& F, int r, LAS float* scr) {
  unsigned char* ws = F.ws; const int lane = fresh_lane();
  if (r < 4 * I_GU) { const int j = r / I_GU, it = r % I_GU, kb = it / 88, nb = it % 88, n0 = nb * 32;
    const float* W = j == 0 ? F.in[6] : j == 1 ? F.in[7] : j == 2 ? F.in[19] : F.in[20]; bf16_t* WT = (bf16_t*)(ws + (j < 2 ? WS_WGU1 : WS_WGU2));
    p0_transpose_item(W, DFF, kb * 64, n0, WT, DM, (n0 >> 7) * 256 + (j & 1) * 128 + (n0 & 127), false, nullptr, 1.f, scr, lane); return; }
  r -= 4 * I_GU;
  if (r < 2 * I_DN) { const int j = r / I_DN, it = r % I_DN, kb = it / 32, nb = it % 32;
    p0_transpose_item(j ? F.in[21] : F.in[8], DM, kb * 64, nb * 32, (bf16_t*)(ws + (j ? WS_WD2 : WS_WD1)), DFF, nb * 32, false, nullptr, 1.f, scr, lane); return; }
  r -= 2 * I_DN;
  if (r < I_WIN) { const int kb = r / 85, nb = r % 85, n0 = 512 + nb * 32; int dr; bool perm = false;
    if (n0 < 896) dr = 3072 + (n0 - 512); else if (n0 < 1152) dr = 3456 + (n0 - 896); else if (n0 < 1184) { dr = 3712; perm = true; } else dr = 1024 + (n0 - 1184);
    p0_transpose_item(F.in[10], 3232, kb * 64, n0, (bf16_t*)(ws + WS_WIN), DM, dr, perm, nullptr, 1.f, scr, lane); return; }
  r -= I_WIN;
  if (r < I_WQ) { const int kb = r / 24, nb = r % 24, n0 = nb * 32;
    p0_transpose_item(F.in[12], NQ, kb * 64, n0, (bf16_t*)(ws + WS_WQ), QLR, n0, (n0 % 96) == 64, F.in[11], SCQ, scr, lane); return; }
  r -= I_WQ;
  if (r < I_WKV) { const int kb = r / 32, nb = r % 32;
    p0_transpose_item(F.in[14], NKV, kb * 64, nb * 32, (bf16_t*)(ws + WS_WKV), KVLR, nb * 32, false, F.in[13], 1.f, scr, lane); return; }
  r -= I_WKV;
  if (r < 2 * I_WF) { const int j = r / I_WF, it = r % I_WF, kb = it / 32, nb = it % 32;
    p0_transpose_item(j ? F.in[16] : F.in[15], DM, kb * 64, nb * 32, (bf16_t*)(ws + (j ? WS_WM : WS_WF)), 512, nb * 32, false, nullptr, 1.f, scr, lane); return; }
  r -= 2 * I_WF;
  { const int kb = r / 32, nb = r % 32;
    p0_transpose_item(F.in[17], DM, kb * 64, nb * 32, (bf16_t*)(ws + WS_WO), DM, nb * 32, false, nullptr, 1.f, scr, lane); }
}
__device__ __forceinline__ void p0_mod_item(const Frame& F, int it) {
  const int nb = it % 144, kc = it / 144, n = nb * 64 + fresh_lane(); const float* cin = F.in[1]; const float* W = F.in[3] + (size_t)(kc * 32) * NADA + n;
  float acc[4] = {0.f, 0.f, 0.f, 0.f};
#pragma unroll 8
  for (int kk = 0; kk < 32; ++kk) { const float w = W[(size_t)kk * NADA];
#pragma unroll
    for (int b = 0; b < 4; ++b) { const float cv = cin[b * DM + kc * 32 + kk]; acc[b] += cv * fast_sigmoid(cv) * w; } }
  float* mod = (float*)(F.ws + OFF_MOD);
#pragma unroll
  for (int b = 0; b < 4; ++b) { float v = acc[b]; if (kc == 0) v += F.in[4][n]; __hip_atomic_fetch_add(mod + b * NADA + n, v, __ATOMIC_RELAXED, __HIP_MEMORY_SCOPE_AGENT); }
}
__device__ __forceinline__ void p0_fold_item(const Frame& F, int it) {
  LAS float* tile = (LAS float*)(F.lds + FOLD_OFF); LAS float* cosT = tile + 2048;
  const int kc = it >> 2, g = it & 3, k0 = kc * 16, tid = F.wave * 64 + fresh_lane();
  { const int idx = tid * 4, kk = idx >> 7, c = idx & 127; *(LAS f32x4*)(tile + idx) = *(const f32x4*)(F.in[10] + (size_t)(k0 + kk) * 3232 + g * 128 + c); }
  if (tid < 128) cosT[tid] = __builtin_amdgcn_cosf((float)tid * (1.0f / 128.0f)) * 0.08838834764831845f;
  __syncthreads();
  const int n = tid & 255, ri = n >> 7, m = n & 127, kh = tid >> 8;
  float acc[8] = {0.f, 0.f, 0.f, 0.f, 0.f, 0.f, 0.f, 0.f};
  for (int c = 0; c < 128; ++c) { const int idx = (m * c) & 127; const float tv = ri ? -cosT[(idx - 32) & 127] : cosT[idx];
#pragma unroll
    for (int q = 0; q < 8; ++q) acc[q] += tile[(kh * 8 + q) * 128 + c] * tv; }
  u32x4 o; o.x = cvt_pk_bf16(acc[0], acc[1]); o.y = cvt_pk_bf16(acc[2], acc[3]); o.z = cvt_pk_bf16(acc[4], acc[5]); o.w = cvt_pk_bf16(acc[6], acc[7]);
  *(u32x4*)((bf16_t*)(F.ws + WS_WIN) + (size_t)(ri * 512 + g * 128 + m) * DM + k0 + kh * 8) = o;
  __syncthreads();
}
__device__ __forceinline__ void p0_prologue(const Frame& F) {
  unsigned char* ws = F.ws;
  for (int it = blockIdx.x; it < 256; it += F.G) p0_fold_item(F, it);
  LAS float* scr = (LAS float*)(F.lds + F.wave * 16384);
  const int gw = F.vcu * NWAVES + F.wave, NGW = F.G * NWAVES;
  for (int it = gw; it < NMODI; it += NGW) p0_mod_item(F, it);
  for (int it = gw; it < NTRANS; it += NGW) p0_trans_dispatch(F, it, scr);
  const int gt = blockIdx.x * 512 + F.wave * 64 + fresh_lane(), NGT = F.G * 512;
  { const int* pos = (const int*)F.in[2]; float* rope = (float*)(ws + WS_ROPE);
    for (int e = gt; e < MTOK * 16; e += NGT) { const int tok = e >> 4, j = e & 15;
      const double c4 = (j & 3) == 0 ? 1.0 : (j & 3) == 1 ? 0.5623413251903491 : (j & 3) == 2 ? 0.31622776601683794 : 0.1778279410038923;
      const double p10 = (j >> 2) == 0 ? 1.0 : (j >> 2) == 1 ? 0.1 : (j >> 2) == 2 ? 0.01 : 0.001;
      const float inv = (float)(c4 * p10); const float ang = (float)pos[tok] * inv;
      double t = (double)ang * 0.15915494309189535; t -= __builtin_floor(t); const float tf = (float)t;
      rope[(size_t)tok * 32 + j] = __builtin_amdgcn_cosf(tf); rope[(size_t)tok * 32 + 16 + j] = __builtin_amdgcn_sinf(tf); } }
  { float* tw = (float*)(ws + WS_TW);
    for (int e = gt; e < 64 * 128; e += NGT) { const int c = e >> 7, b2 = e & 127; const float t = (float)((c * b2) & 8191) * (1.0f / 8192.0f);
      tw[2 * e] = __builtin_amdgcn_cosf(t); tw[2 * e + 1] = __builtin_amdgcn_sinf(t); } }
  { bf16_t* c64 = (bf16_t*)(ws + WS_C64);
    for (int e = gt; e < 4096; e += NGT) { const int c = e >> 6, a = e & 63; const float t = (float)((c * a) & 63) * (1.0f / 64.0f);
      const float cs = __builtin_amdgcn_cosf(t) * 0.125f, sn = __builtin_amdgcn_sinf(t) * 0.125f;
      c64[e] = (bf16_t)attn::f2bf(cs); c64[4096 + e] = (bf16_t)attn::f2bf(sn); c64[8192 + e] = (bf16_t)attn::f2bf(-sn); } }
  { bf16_t* c128 = (bf16_t*)(ws + WS_C128);
    for (int e = gt; e < 16384; e += NGT) { const int d = e >> 7, b2 = e & 127; const float t = (float)((d * b2) & 127) * (1.0f / 128.0f);
      c128[e] = (bf16_t)attn::f2bf(__builtin_amdgcn_cosf(t) * 0.08838834764831845f); c128[16384 + e] = (bf16_t)attn::f2bf(__builtin_amdgcn_sinf(t) * 0.08838834764831845f); } }
  { u32x4* z = (u32x4*)((bf16_t*)(ws + WS_WIN) + (size_t)3744 * DM);
    for (int e = gt; e < 96 * DM / 8; e += NGT) z[e] = (u32x4){0u, 0u, 0u, 0u}; }
}
__device__ __forceinline__ void norm_mod_phase(const Frame& F, const float* x, const float* g, const float* mod_shift, const float* mod_scale, bf16_t* H) {
  const int gw = F.vcu * NWAVES + F.wave, NGW = F.G * NWAVES, lane = fresh_lane();
  for (int ch = gw; ch < MTOK / 16; ch += NGW) {
    const int row0 = ch * 16, b = row0 / SEQ;
    f32x4 av[4], bv[4];
#pragma unroll
    for (int j = 0; j < 4; ++j) { const int col = 4 * lane + 256 * j; const f32x4 gg = *(const f32x4*)(g + col), sc = *(const f32x4*)(mod_scale + (size_t)b * NADA + col);
      av[j] = gg * (1.0f + sc); bv[j] = *(const f32x4*)(mod_shift + (size_t)b * NADA + col); }
    for (int r = 0; r < 16; ++r) {
      const f32x4* xr = (const f32x4*)(x + (size_t)(row0 + r) * DM) + lane; f32x4 v[4]; float s = 0.f;
#pragma unroll
      for (int j = 0; j < 4; ++j) { v[j] = xr[64 * j]; s += (v[j][0] * v[j][0] + v[j][1] * v[j][1]) + (v[j][2] * v[j][2] + v[j][3] * v[j][3]); }
      const float rs = rsqrtf(wave_sum(s) * (1.0f / DM) + NORM_EPS);
      u32x2* o8 = (u32x2*)(H + (size_t)(row0 + r) * DM) + lane;
#pragma unroll
      for (int j = 0; j < 4; ++j) { const f32x4 y = v[j] * rs * av[j] + bv[j]; u32x2 w; w.x = cvt_pk_bf16(y[0], y[1]); w.y = cvt_pk_bf16(y[2], y[3]); o8[64 * j] = w; }
    }
  }
}
__device__ __forceinline__ void final_norm_phase(const Frame& F, float* x, const float* g) {
  const int gw = F.vcu * NWAVES + F.wave, NGW = F.G * NWAVES, lane = fresh_lane();
  f32x4 gv[4];
#pragma unroll
  for (int j = 0; j < 4; ++j) gv[j] = *(const f32x4*)(g + 4 * lane + 256 * j);
  for (int row = gw; row < MTOK; row += NGW) {
    f32x4* xr = (f32x4*)(x + (size_t)row * DM) + lane; f32x4 v[4]; float s = 0.f;
#pragma unroll
    for (int j = 0; j < 4; ++j) { v[j] = xr[64 * j]; s += (v[j][0] * v[j][0] + v[j][1] * v[j][1]) + (v[j][2] * v[j][2] + v[j][3] * v[j][3]); }
    const float rs = rsqrtf(wave_sum(s) * (1.0f / DM) + NORM_EPS);
#pragma unroll
    for (int j = 0; j < 4; ++j) xr[64 * j] = v[j] * rs * gv[j];
  }
}

constexpr int NPHASE = 14;
__global__ void __launch_bounds__(NWAVES * 64, 2) mk_fwd(Args args) {
  extern __shared__ __attribute__((aligned(16))) unsigned char lds_raw[];
  Frame F;
  F.lds = (LAS unsigned char*)lds_raw; F.wave = __builtin_amdgcn_readfirstlane(threadIdx.x >> 6);
  F.G = gridDim.x; { const int bx = blockIdx.x; F.vcu = (F.G % 8 == 0) ? (bx % 8) * (F.G / 8) + bx / 8 : bx; }
  F.in = args.in; F.out = args.out; F.ws = args.ws;
  unsigned char* ws = args.ws;
  for (int u = threadIdx.x; u < (LDS_BYTES - LDSCTL_OFF) / 4; u += NWAVES * 64) ((LAS unsigned*)(F.lds + LDSCTL_OFF))[u] = 0u;
  __syncthreads();
#if MK_SINGLE
  XcdBarrier bar = xcd_barrier_post((unsigned*)(ws + WS_CTL) + CW_BAR, (volatile LAS unsigned*)(F.lds + MISC_OFF) + 8);
#define GRID_BAR() xcd_barrier(bar)
#else
#define GRID_BAR() do {} while (0)
#endif
  const int lo = args.ph_lo, hi = args.ph_hi;
#ifndef PH_MASK
#define PH_MASK 0xFFFF
#endif
#define IN(k) (((PH_MASK >> (k)) & 1) && lo <= (k) && (k) < hi)
#define SEAM(k) do { if (IN(k) && IN((k) + 1)) GRID_BAR(); } while (0)
  const float* mod = (const float*)(ws + OFF_MOD);
  float* rsq_q = (float*)(ws + OFF_RSQQ); float* rsq_kv = (float*)(ws + OFF_RSQKV);
  const float* rope = (const float*)(ws + WS_ROPE);
  bf16_t* H = (bf16_t*)(ws + WS_H); bf16_t* ACT = (bf16_t*)(ws + WS_BIG);
  bf16_t* Vb = (bf16_t*)(ws + WS_V); bf16_t* Yb = (bf16_t*)(ws + WS_Y); bf16_t* Fb = (bf16_t*)(ws + WS_F); bf16_t* ZL = (bf16_t*)(ws + WS_ZL); bf16_t* Ob = (bf16_t*)(ws + WS_O);
  bf16_t* Qb = (bf16_t*)(ws + WS_H); bf16_t* KVb = (bf16_t*)(ws + WS_KV); bf16_t* KRb = (bf16_t*)(ws + WS_KR); bf16_t* GT = (bf16_t*)(ws + WS_GATES); bf16_t* YM = (bf16_t*)(ws + WS_H);
  const int cu = (int)blockIdx.x;

  if (IN(0)) { p0_prologue(F); } SEAM(0);
#ifndef DUP
#define DUP 0
#endif
  if (IN(1)) { for (int rep = 0; rep < 1 + ((DUP >> 0) & 1); ++rep) norm_mod_phase(F, F.in[0], F.in[5], mod + 0 * DM, mod + 1 * DM, H); } SEAM(1);
  if (IN(2)) { for (int rep = 0; rep < 1 + ((DUP >> 1) & 1); ++rep) { pg8::Gemm g{H, (const bf16_t*)(ws + WS_WGU1), MTOK, 2 * DFF, DM, DM, DM}; pg8::StaticOrder S; S.init(MTOK, 2 * DFF, F.G, cu);
    pg8::EpiSwiglu E{ACT}; pg8::gemm_phase(F.lds, g, S, E, F.wave); } } SEAM(2);
  if (IN(3)) { pg8::Gemm g{ACT, (const bf16_t*)(ws + WS_WD1), MTOK, DM, DFF, DFF, DFF}; pg8::StaticOrder S; S.init(MTOK, DM, F.G, cu);
    pg8::EpiResid E{F.in[0], F.out, mod + 2 * DM, 0.5f}; pg8::gemm_phase(F.lds, g, S, E, F.wave); } SEAM(3);
  if (IN(4)) { norm_mod_phase(F, F.out, F.in[9], mod + 3 * DM, mod + 4 * DM, H); } SEAM(4);
  if (IN(5)) { pg8::Gemm g{H, (const bf16_t*)(ws + WS_WIN), MTOK, NWIN, DM, DM, DM}; pg8::StaticOrder S; S.init(MTOK, NWIN, F.G, cu);
    pg8::EpiWin E{Vb, GT, ZL, KRb, rsq_q, rsq_kv, rope}; pg8::gemm_phase(F.lds, g, S, E, F.wave); } SEAM(5);
#ifndef P6_PART
#define P6_PART 7
#endif
  if (IN(6)) {
    if (P6_PART & 1) { pg8::Gemm g{ZL, (const bf16_t*)(ws + WS_WQ), MTOK, NQ, QLR, ZLW, QLR}; pg8::StaticOrder S; S.init(MTOK, NQ, F.G, cu);
      pg8::EpiQ E{Qb, rsq_q, rope}; pg8::gemm_phase(F.lds, g, S, E, F.wave); }
    if (P6_PART & 2) { pg8::Gemm g{ZL + QLR, (const bf16_t*)(ws + WS_WKV), MTOK, NKV, KVLR, ZLW, KVLR}; pg8::StaticOrder S; S.init(MTOK, NKV, F.G, F.G - 1 - cu);
      pg8::EpiKV E{KVb, rsq_kv}; pg8::gemm_phase(F.lds, g, S, E, F.wave); }
    if (P6_PART & 4) for (int rep = 0; rep < 1 + ((DUP >> 2) & 1); ++rep) fft::stage1(Vb, Yb, (const bf16_t*)(ws + WS_C64), (const float*)(ws + WS_TW), F.lds, F.vcu, F.G, F.wave);
  } SEAM(6);
  if (IN(7)) {
    for (int rep = 0; rep < 1 + ((DUP >> 3) & 1); ++rep) fft::stage2(Yb, Fb, (const bf16_t*)(ws + WS_C128), F.lds, F.vcu, F.G, F.wave);
    { const int xl = F.vcu >> 5, qb = F.vcu & 31;
      for (int i = 0; i < 4 * (1 + ((DUP >> 4) & 1)); ++i) { const int bh = xl + 8 * (i & 3); if (F.G == 256) attn::attn_unit(bh >> 3, bh & 7, qb, Qb, KVb, KRb, Ob, F.lds, F.wave); }
      if (F.G != 256) for (int uu = cu; uu < 1024; uu += F.G) attn::attn_unit(uu >> 8, (uu >> 5) & 7, uu & 31, Qb, KVb, KRb, Ob, F.lds, F.wave); }
  } SEAM(7);
#ifndef MERGE_PART
#define MERGE_PART 3
#endif
  if (IN(8)) {
#ifndef DBG_SRC
#define DBG_SRC 0
#endif
    if (MERGE_PART & 1) { pg8::Gemm g{DBG_SRC == 1 ? Vb : DBG_SRC == 2 ? Yb : Fb, (const bf16_t*)(ws + WS_WF), MTOK, DM, 512, DBG_SRC ? 1024 : 512, 512}; pg8::StaticOrder S; S.init(MTOK, DM, F.G, cu);
      pg8::EpiMerge<false, 0> E{YM, GT}; pg8::gemm_phase(F.lds, g, S, E, F.wave); }
    if (MERGE_PART == 3) { pg8::Gemm g{Ob, (const bf16_t*)(ws + WS_WM), MTOK, DM, 512, 512, 512}; pg8::StaticOrder S; S.init(MTOK, DM, F.G, cu);
      pg8::EpiMerge<true, 1024> E{YM, GT}; pg8::gemm_phase(F.lds, g, S, E, F.wave); }
    if (MERGE_PART == 2) { pg8::Gemm g{Ob, (const bf16_t*)(ws + WS_WM), MTOK, DM, 512, 512, 512}; pg8::StaticOrder S; S.init(MTOK, DM, F.G, cu);
      pg8::EpiMerge<false, 1024> E{YM, GT}; pg8::gemm_phase(F.lds, g, S, E, F.wave); }
  } SEAM(8);
  if (IN(9)) { pg8::Gemm g{YM, (const bf16_t*)(ws + WS_WO), MTOK, DM, DM, DM, DM}; pg8::StaticOrder S; S.init(MTOK, DM, F.G, cu);
    pg8::EpiResid E{F.out, F.out, mod + 5 * DM, 1.0f}; pg8::gemm_phase(F.lds, g, S, E, F.wave); } SEAM(9);
  if (IN(10)) { norm_mod_phase(F, F.out, F.in[18], mod + 6 * DM, mod + 7 * DM, H); } SEAM(10);
  if (IN(11)) { pg8::Gemm g{H, (const bf16_t*)(ws + WS_WGU2), MTOK, 2 * DFF, DM, DM, DM}; pg8::StaticOrder S; S.init(MTOK, 2 * DFF, F.G, cu);
    pg8::EpiSwiglu E{ACT}; pg8::gemm_phase(F.lds, g, S, E, F.wave); } SEAM(11);
  if (IN(12)) { pg8::Gemm g{ACT, (const bf16_t*)(ws + WS_WD2), MTOK, DM, DFF, DFF, DFF}; pg8::StaticOrder S; S.init(MTOK, DM, F.G, cu);
    pg8::EpiResid E{F.out, F.out, mod + 8 * DM, 0.5f}; pg8::gemm_phase(F.lds, g, S, E, F.wave); } SEAM(12);
  if (IN(13)) { final_norm_phase(F, F.out, F.in[22]); }
#undef IN
#undef SEAM
}

extern "C" void kernel_launch(void* const* d_in, const int* in_sizes, int n_in, void* d_out, int out_size, void* d_ws, size_t ws_size, hipStream_t stream) {
  static int grid = 0;
  if (grid == 0) {
    if (n_in != 23 || in_sizes[0] != MTOK * DM || out_size != MTOK * DM || ws_size < WS_END) {
      fprintf(stderr, "kernel_launch: unexpected shapes n_in %d in0 %d out %d ws %zu (need >= %zu)\n", n_in, n_in > 0 ? in_sizes[0] : -1, out_size, ws_size, (size_t)WS_END); grid = -1; return; }
    int dev = 0, cus = 0;
    if (hipGetDevice(&dev) != hipSuccess || hipDeviceGetAttribute(&cus, hipDeviceAttributeMultiprocessorCount, dev) != hipSuccess) { grid = -1; return; }
    if (hipFuncSetAttribute((const void*)mk_fwd, hipFuncAttributeMaxDynamicSharedMemorySize, LDS_BYTES) != hipSuccess) { fprintf(stderr, "kernel_launch: hipFuncSetAttribute failed\n"); grid = -1; return; }
    grid = cus;
  }
  if (grid < 0) return;
  (void)hipMemsetAsync((char*)d_ws + WS_CTL, 0, CTL_ZERO_BYTES, stream);
  Args a{};
  for (int i = 0; i < 23; ++i) a.in[i] = (const float*)d_in[i];
  a.out = (float*)d_out; a.ws = (unsigned char*)d_ws;
#if MK_SINGLE
  a.ph_lo = 0; a.ph_hi = NPHASE;
  hipLaunchKernelGGL(mk_fwd, dim3(grid), dim3(NWAVES * 64), LDS_BYTES, stream, a);
#else
  for (int p = 0; p < NPHASE; ++p) { a.ph_lo = p; a.ph_hi = p + 1; hipLaunchKernelGGL(mk_fwd, dim3(grid), dim3(NWAVES * 64), LDS_BYTES, stream, a); }
#endif
}
```

```cpp
#include <hip/hip_runtime.h>
#include <cstdio>
#include <cstdint>

#define LAS __attribute__((address_space(3)))
#define GAS __attribute__((address_space(1)))
typedef unsigned short bf16_t;
typedef short bf16x8 __attribute__((ext_vector_type(8)));
typedef short s16x4 __attribute__((ext_vector_type(4)));
typedef float f32x4 __attribute__((ext_vector_type(4)));
typedef float f32x2 __attribute__((ext_vector_type(2)));
typedef float f32x16 __attribute__((ext_vector_type(16)));
typedef unsigned u32x4 __attribute__((ext_vector_type(4)));
typedef unsigned u32x2 __attribute__((ext_vector_type(2)));

#ifndef MK_SINGLE
#define MK_SINGLE 1
#endif

constexpr int BATCH = 4, SEQ = 8192, DM = 1024, MTOK = BATCH * SEQ, DFF = 2816, NADA = 9 * DM;
constexpr int NWIN = 3840;
constexpr int QLR = 384, KVLR = 256, NQ = 768, NKV = 1024, ZLW = 768;
constexpr float NORM_EPS = 1e-6f;
constexpr float SCQ = 0.10206207261596575f * 1.4426950408889634f;

constexpr size_t MiB = 1u << 20;
constexpr size_t WS_CTL = 0, CTL_ZERO_BYTES = 2 * MiB;
constexpr size_t OFF_MOD = 256 * 1024, OFF_RSQQ = 512 * 1024, OFF_RSQKV = 640 * 1024;
constexpr size_t WS_ROPE = 2 * MiB;
constexpr size_t WS_TW = 6 * MiB;
constexpr size_t WS_C64 = 6 * MiB + 64 * 1024, WS_S64 = WS_C64 + 8192, WS_NS64 = WS_S64 + 8192;
constexpr size_t WS_C128 = 6 * MiB + 128 * 1024, WS_S128 = WS_C128 + 32768;
constexpr size_t WS_WGU1 = 8 * MiB, WS_WD1 = 19 * MiB, WS_WGU2 = 25 * MiB, WS_WD2 = 36 * MiB, WS_WIN = 42 * MiB;
constexpr size_t WS_WQ = 50 * MiB, WS_WKV = 51 * MiB, WS_WF = 52 * MiB, WS_WM = 53 * MiB, WS_WO = 54 * MiB;
constexpr size_t WS_H = 64 * MiB;
constexpr size_t WS_KV = 128 * MiB;
constexpr size_t WS_GATES = 192 * MiB;
constexpr size_t WS_KR = 320 * MiB;
constexpr size_t WS_BIG = 322 * MiB;
constexpr size_t WS_V = WS_BIG, WS_F = WS_BIG, WS_Y = WS_BIG + 64 * MiB, WS_ZL = WS_BIG + 128 * MiB, WS_O = WS_ZL;
constexpr size_t WS_END = 498 * MiB;
constexpr int CW_BAR = 4096;

typedef __bf16 bf16x2_t __attribute__((ext_vector_type(2)));
__device__ __forceinline__ unsigned cvt_pk_bf16(float lo, float hi) { f32x2 v = {lo, hi}; bf16x2_t b = __builtin_convertvector(v, bf16x2_t); return __builtin_bit_cast(unsigned, b); }
__device__ __forceinline__ float bf_lo(unsigned w) { return __uint_as_float(w << 16); }
__device__ __forceinline__ float bf_hi(unsigned w) { return __uint_as_float(w & 0xffff0000u); }
__device__ __forceinline__ u32x4 pack8(f32x4 a, f32x4 b) { u32x4 w; w.x = cvt_pk_bf16(a[0], a[1]); w.y = cvt_pk_bf16(a[2], a[3]); w.z = cvt_pk_bf16(b[0], b[1]); w.w = cvt_pk_bf16(b[2], b[3]); return w; }
__device__ __forceinline__ float fast_sigmoid(float v) { return __builtin_amdgcn_rcpf(1.0f + __builtin_amdgcn_exp2f(-1.4426950408889634f * v)); }
__device__ __forceinline__ float wave_sum(float v) {
#pragma unroll
  for (int o = 1; o < 64; o <<= 1) v += __shfl_xor(v, o);
  return v;
}
__device__ __forceinline__ int fresh_lane() { int l; asm volatile("v_mbcnt_lo_u32_b32 %0, -1, 0\n\tv_mbcnt_hi_u32_b32 %0, -1, %0" : "=v"(l)); return l; }
#define LDS_WAIT() asm volatile("s_waitcnt lgkmcnt(0)" ::: "memory")
#define VM_WAIT() asm volatile("s_waitcnt vmcnt(0)" ::: "memory")

namespace pg8 {
constexpr int BM = 256, BK = 64, HALF = 128, HTB = HALF * BK * 2, STAGE_BYTES = 8 * HTB, NXCD = 8, WGM = 8;
__host__ __device__ __forceinline__ int lds_byte(int r, int c) { const int st = (r >> 4) * 2 + (c >> 5), rr = r & 15, cc = c & 31, ob = rr * 64 + cc * 2; return st * 1024 + (ob ^ (((ob >> 9) & 1) << 5)); }
__host__ __device__ __forceinline__ void stage_rc(int b, int& R, int& C) { const int st = b / 1024, sb = b % 1024, swz = sb ^ (((sb >> 9) & 1) << 5); R = (st >> 1) * 16 + swz / 64; C = (st & 1) * 32 + (swz % 64) / 2; }
__host__ __device__ __forceinline__ int perm32(int rho) { const int n = rho >> 4, i = rho & 15; return 8 * (i >> 2) + 4 * n + (i & 3); }
struct Unit { int pm, pn; };
struct Gemm { const bf16_t* A; const bf16_t* Bt; int M, N, K, lda, ldb; };
struct StaticOrder {
  int nM, nN, nwg, G, c;
  __host__ __device__ void init(int M, int N, int G_, int c_) { nM = M / BM; nN = N / BM; nwg = nM * nN; G = G_; c = c_; }
  __host__ __device__ bool next(int i, Unit& u) const {
    const long L = (long)i * G + c; if (L >= nwg) return false;
    int wgid = (int)L; { const int q = nwg / NXCD, r = nwg % NXCD, xcd = wgid % NXCD, off = wgid / NXCD; wgid = (xcd < r ? xcd * (q + 1) : r * (q + 1) + (xcd - r) * q) + off; }
    const int nig = WGM * nN, gid = wgid / nig, fm = gid * WGM, gsz = (nM - fm) < WGM ? (nM - fm) : WGM;
    u.pm = fm + ((wgid % nig) % gsz); u.pn = (wgid % nig) / gsz; return true;
  }
};
template <class Epi, class Sched, bool ALIGN_EPI = true, bool SP2 = true>
__device__ __forceinline__ void gemm_phase(LAS unsigned char* lds, const Gemm g, const Sched& S, const Epi& E, const int wid) {
  const int lane0 = fresh_lane();
  const int tid = wid * 64 + lane0, wr = wid >> 2, wc = wid & 3, fr = lane0 & 15, fq = lane0 >> 4;
  const int K = g.K, nt = K / BK;
  unsigned voffA[2], voffB[2];
#pragma unroll
  for (int i = 0; i < 2; ++i) { int R, C; stage_rc(tid * 16 + i * 8192, R, C); const int Rb = Epi::PERM ? ((R & ~31) + perm32(R & 31)) : R;
    voffA[i] = (unsigned)(R * g.lda + C) * 2u; voffB[i] = (unsigned)(Rb * g.ldb + C) * 2u; }
  const size_t kstep = (size_t)(BK * 2);
  const size_t hstepA = (size_t)HALF * g.lda * 2, hstepB = (size_t)HALF * g.ldb * 2;
  const size_t tstepA = 2 * hstepA, tstepB = 2 * hstepB;
  const unsigned ldsw = (unsigned)wid * 1024u;
  const int aoff = lds_byte(wr * 64 + fr, fq * 8), boff = lds_byte(wc * 32 + fr, fq * 8);
#define PG8_SA(b, h) (((b) * 2 + (h)) * HTB)
#define PG8_SB(b, h) ((4 + (b) * 2 + (h)) * HTB)
#define PG8_STAGE(bufoff, gbase, voff) do { _Pragma("unroll") for (int _i = 0; _i < 2; ++_i) \
    __builtin_amdgcn_global_load_lds((const unsigned*)((const char*)(gbase) + (voff)[_i]), (LAS unsigned*)(lds + (bufoff) + ldsw + _i * 8192), 16, 0, 0); } while (0)
#define PG8_LDA(dst, b, h) do { _Pragma("unroll") for (int m = 0; m < 4; ++m) _Pragma("unroll") for (int k = 0; k < 2; ++k) dst[m][k] = *(const LAS bf16x8*)(lds + PG8_SA(b, h) + aoff + m * 2048 + k * 1024); } while (0)
#define PG8_LDB(dst, b, h) do { _Pragma("unroll") for (int n = 0; n < 2; ++n) _Pragma("unroll") for (int k = 0; k < 2; ++k) dst[n][k] = *(const LAS bf16x8*)(lds + PG8_SB(b, h) + boff + n * 2048 + k * 1024); } while (0)
#define PG8_MMA(ai, bj, At, Bt) do { __builtin_amdgcn_s_setprio(1); _Pragma("unroll") for (int m = 0; m < 4; ++m) _Pragma("unroll") for (int n = 0; n < 2; ++n) _Pragma("unroll") for (int k = 0; k < 2; ++k) \
    acc[ai][bj][m][n] = __builtin_amdgcn_mfma_f32_16x16x32_bf16(Bt[n][k], At[m][k], acc[ai][bj][m][n], 0, 0, 0); __builtin_amdgcn_s_setprio(0); } while (0)
#define PG8_WAIT_V(n) asm volatile("s_waitcnt vmcnt(" #n ")" ::: "memory")
#define PG8_WAIT_L(n) asm volatile("s_waitcnt lgkmcnt(" #n ")" ::: "memory")
#define PG8_BAR __builtin_amdgcn_s_barrier()
#define PG8_SCHED __builtin_amdgcn_sched_barrier(0)
  Unit cur, nxt; int ui = 0;
  if (!S.next(0, cur)) return;
  f32x4 acc[2][2][4][2];
#pragma unroll
  for (int a = 0; a < 2; ++a)
#pragma unroll
    for (int b = 0; b < 2; ++b)
#pragma unroll
      for (int m = 0; m < 4; ++m)
#pragma unroll
        for (int n = 0; n < 2; ++n) acc[a][b][m][n] = (f32x4){0.f, 0.f, 0.f, 0.f};
  bf16x8 At[4][2], B0[2][2], B1[2][2];
  const char* cA = (const char*)g.A + (size_t)cur.pm * tstepA; const char* cB = (const char*)g.Bt + (size_t)cur.pn * tstepB;
  if constexpr (SP2) {
    PG8_STAGE(PG8_SB(0, 0), cB, voffB); PG8_STAGE(PG8_SB(0, 1), cB + hstepB, voffB); PG8_STAGE(PG8_SA(0, 0), cA, voffA); PG8_STAGE(PG8_SA(0, 1), cA + hstepA, voffA);
    if (wr == 1) PG8_BAR;
    PG8_WAIT_V(2); PG8_BAR;
    PG8_STAGE(PG8_SB(1, 0), cB + kstep, voffB); PG8_STAGE(PG8_SA(1, 0), cA + kstep, voffA); PG8_STAGE(PG8_SB(1, 1), cB + hstepB + kstep, voffB);
    PG8_WAIT_V(6); PG8_BAR;
  } else {
    PG8_STAGE(PG8_SB(0, 0), cB, voffB); PG8_STAGE(PG8_SA(0, 0), cA, voffA); PG8_STAGE(PG8_SB(0, 1), cB + hstepB, voffB); PG8_STAGE(PG8_SA(0, 1), cA + hstepA, voffA);
    if (wr == 1) PG8_BAR;
    PG8_WAIT_V(4); PG8_BAR;
    PG8_STAGE(PG8_SB(1, 0), cB + kstep, voffB); PG8_STAGE(PG8_SA(1, 0), cA + kstep, voffA); PG8_STAGE(PG8_SB(1, 1), cB + hstepB + kstep, voffB);
    PG8_WAIT_V(6); PG8_BAR;
  }
  for (;;) {
    const bool has_next = S.next(ui + 1, nxt);
    const char* nA = has_next ? (const char*)g.A + (size_t)nxt.pm * tstepA : cA; const char* nB = has_next ? (const char*)g.Bt + (size_t)nxt.pn * tstepB : cB;
    for (int t = 0; t < nt; t += 2) {
      const bool last = (t == nt - 2);
      const char* a1 = cA + (size_t)(t + 1) * kstep;
      const char* a2 = last ? nA : cA + (size_t)(t + 2) * kstep; const char* b2 = last ? nB : cB + (size_t)(t + 2) * kstep;
      const char* a3 = a2 + kstep; const char* b3 = b2 + kstep;
      if constexpr (SP2) {
        PG8_LDB(B0, 0, 0); PG8_LDB(B1, 0, 1); PG8_SCHED; PG8_LDA(At, 0, 0); PG8_STAGE(PG8_SA(1, 1), a1 + hstepA, voffA);
        PG8_WAIT_V(8); PG8_WAIT_L(0); PG8_BAR; PG8_MMA(0, 0, At, B0); PG8_MMA(0, 1, At, B1); PG8_BAR; PG8_SCHED;
        PG8_LDA(At, 0, 1); PG8_STAGE(PG8_SB(0, 0), b2, voffB); PG8_STAGE(PG8_SB(0, 1), b2 + hstepB, voffB); PG8_STAGE(PG8_SA(0, 0), a2, voffA);
        PG8_WAIT_V(8); PG8_WAIT_L(0); PG8_BAR; PG8_MMA(1, 0, At, B0); PG8_MMA(1, 1, At, B1); PG8_BAR; PG8_SCHED;
        PG8_LDB(B0, 1, 0); PG8_LDB(B1, 1, 1); PG8_SCHED; PG8_LDA(At, 1, 0); PG8_STAGE(PG8_SA(0, 1), a2 + hstepA, voffA);
        PG8_WAIT_V(8); PG8_WAIT_L(0); PG8_BAR; PG8_MMA(0, 0, At, B0); PG8_MMA(0, 1, At, B1); PG8_BAR; PG8_SCHED;
        PG8_LDA(At, 1, 1); PG8_STAGE(PG8_SB(1, 0), b3, voffB); PG8_STAGE(PG8_SB(1, 1), b3 + hstepB, voffB); PG8_STAGE(PG8_SA(1, 0), a3, voffA);
        PG8_WAIT_V(8); PG8_WAIT_L(0); PG8_BAR; PG8_MMA(1, 0, At, B0); PG8_MMA(1, 1, At, B1); PG8_BAR; PG8_SCHED;
      } else {
        PG8_LDB(B0, 0, 0); PG8_SCHED; PG8_LDA(At, 0, 0); PG8_STAGE(PG8_SA(1, 1), a1 + hstepA, voffA);
        PG8_WAIT_L(8); PG8_BAR; PG8_WAIT_L(0); PG8_MMA(0, 0, At, B0); PG8_BAR; PG8_SCHED;
        PG8_LDB(B1, 0, 1); PG8_STAGE(PG8_SB(0, 0), b2, voffB);
        PG8_BAR; PG8_WAIT_L(0); PG8_MMA(0, 1, At, B1); PG8_BAR;
        PG8_LDA(At, 0, 1); PG8_STAGE(PG8_SA(0, 0), a2, voffA);
        PG8_BAR; PG8_WAIT_L(0); PG8_MMA(1, 0, At, B0); PG8_BAR; PG8_SCHED;
        PG8_STAGE(PG8_SB(0, 1), b2 + hstepB, voffB);
        PG8_WAIT_V(6); PG8_BAR; PG8_MMA(1, 1, At, B1); PG8_BAR;
        PG8_LDB(B0, 1, 0); PG8_SCHED; PG8_LDA(At, 1, 0); PG8_STAGE(PG8_SA(0, 1), a2 + hstepA, voffA);
        PG8_WAIT_L(8); PG8_BAR; PG8_WAIT_L(0); PG8_MMA(0, 0, At, B0); PG8_BAR; PG8_SCHED;
        PG8_LDB(B1, 1, 1); PG8_STAGE(PG8_SB(1, 0), b3, voffB);
        PG8_BAR; PG8_WAIT_L(0); PG8_MMA(0, 1, At, B1); PG8_BAR;
        PG8_LDA(At, 1, 1); PG8_STAGE(PG8_SA(1, 0), a3, voffA);
        PG8_BAR; PG8_WAIT_L(0); PG8_MMA(1, 0, At, B0); PG8_BAR; PG8_SCHED;
        PG8_STAGE(PG8_SB(1, 1), b3 + hstepB, voffB);
        PG8_WAIT_V(6); PG8_BAR; PG8_MMA(1, 1, At, B1); PG8_BAR;
      }
    }
    if constexpr (ALIGN_EPI) { if (wr == 0) PG8_BAR; }
    { const int le = fresh_lane(); E(acc, cur, wr, wc, le & 15, le >> 4); }
    if (!has_next) break;
#pragma unroll
    for (int a = 0; a < 2; ++a)
#pragma unroll
      for (int b = 0; b < 2; ++b)
#pragma unroll
        for (int m = 0; m < 4; ++m)
#pragma unroll
          for (int n = 0; n < 2; ++n) acc[a][b][m][n] = (f32x4){0.f, 0.f, 0.f, 0.f};
    cur = nxt; cA = nA; cB = nB; ++ui;
    if constexpr (ALIGN_EPI) { if (wr == 1) PG8_BAR; }
  }
  PG8_WAIT_V(0);
  if constexpr (!ALIGN_EPI) { if (wr == 0) PG8_BAR; }
  PG8_BAR;
#undef PG8_SA
#undef PG8_SB
#undef PG8_STAGE
#undef PG8_LDA
#undef PG8_LDB
#undef PG8_MMA
#undef PG8_WAIT_V
#undef PG8_WAIT_L
#undef PG8_BAR
#undef PG8_SCHED
}

typedef f32x4 Acc[2][2][4][2];
struct EpiSwiglu { static constexpr bool PERM = true; bf16_t* O;
  __device__ __forceinline__ void operator()(const Acc& acc, const Unit& u, int wr, int wc, int fr, int fq) const {
    const int row0 = u.pm * BM + wr * 64 + fr, col0 = u.pn * 128 + wc * 32 + 8 * fq;
#pragma unroll
    for (int ai = 0; ai < 2; ++ai)
#pragma unroll
      for (int m = 0; m < 4; ++m) { bf16_t* p = O + (size_t)(row0 + ai * HALF + m * 16) * DFF + col0; f32x4 r[2];
#pragma unroll
        for (int n = 0; n < 2; ++n)
#pragma unroll
          for (int j = 0; j < 4; ++j) { const float gv = acc[ai][0][m][n][j], uv = acc[ai][1][m][n][j]; r[n][j] = gv * fast_sigmoid(gv) * uv; }
        *(u32x4*)p = pack8(r[0], r[1]); }
  }
};
struct EpiResid { static constexpr bool PERM = false; const float* base; float* out; const float* gvec; float coef;
  __device__ __forceinline__ void operator()(const Acc& acc, const Unit& u, int wr, int wc, int fr, int fq) const {
    const int row0 = u.pm * BM + wr * 64 + fr, col0 = u.pn * BM + wc * 32 + 4 * fq; const float* g = gvec + (size_t)(u.pm >> 5) * NADA;
    f32x4 gv[2][2];
#pragma unroll
    for (int bj = 0; bj < 2; ++bj)
#pragma unroll
      for (int n = 0; n < 2; ++n) gv[bj][n] = *(const f32x4*)(g + col0 + bj * HALF + n * 16) * coef;
#pragma unroll
    for (int ai = 0; ai < 2; ++ai)
#pragma unroll
      for (int m = 0; m < 4; ++m) { const size_t off = (size_t)(row0 + ai * HALF + m * 16) * DM + col0;
#pragma unroll
        for (int bj = 0; bj < 2; ++bj)
#pragma unroll
          for (int n = 0; n < 2; ++n) { const f32x4 b = *(const f32x4*)(base + off + bj * HALF + n * 16); *(f32x4*)(out + off + bj * HALF + n * 16) = b + gv[bj][n] * acc[ai][bj][m][n]; } }
  }
};
struct EpiWin { static constexpr bool PERM = true; bf16_t *V, *GATES, *ZL, *KR; float *rsq_q, *rsq_kv; const float* rope;
  __device__ __forceinline__ void operator()(const Acc& acc, const Unit& u, int wr, int wc, int fr, int fq) const {
    const int row0 = u.pm * BM + wr * 64 + fr, cw = wc * 32 + 8 * fq;
    if (u.pn < 4) {
#pragma unroll
      for (int ai = 0; ai < 2; ++ai)
#pragma unroll
        for (int m = 0; m < 4; ++m)
#pragma unroll
          for (int bj = 0; bj < 2; ++bj) *(u32x4*)(V + (size_t)(row0 + ai * HALF + m * 16) * 1024 + u.pn * 256 + bj * HALF + cw) = pack8(acc[ai][bj][m][0], acc[ai][bj][m][1]);
    } else if (u.pn < 12) {
#pragma unroll
      for (int ai = 0; ai < 2; ++ai)
#pragma unroll
        for (int m = 0; m < 4; ++m)
#pragma unroll
          for (int bj = 0; bj < 2; ++bj) { f32x4 a = acc[ai][bj][m][0], b = acc[ai][bj][m][1];
#pragma unroll
            for (int j = 0; j < 4; ++j) { a[j] = fast_sigmoid(a[j]); b[j] = fast_sigmoid(b[j]); }
            *(u32x4*)(GATES + (size_t)(row0 + ai * HALF + m * 16) * 2048 + (u.pn - 4) * 256 + bj * HALF + cw) = pack8(a, b); }
    } else {
#pragma unroll
      for (int bj = 0; bj < 2; ++bj) { const int zc0 = (u.pn - 12) * 256 + bj * HALF;
        if (zc0 < 640) { float* rsq = zc0 < 384 ? rsq_q : rsq_kv;
#pragma unroll
          for (int ai = 0; ai < 2; ++ai)
#pragma unroll
            for (int m = 0; m < 4; ++m) { const int row = row0 + ai * HALF + m * 16; const f32x4 a = acc[ai][bj][m][0], b = acc[ai][bj][m][1];
              *(u32x4*)(ZL + (size_t)row * ZLW + zc0 + cw) = pack8(a, b);
              float ss = (a[0] * a[0] + a[1] * a[1]) + (a[2] * a[2] + a[3] * a[3]) + (b[0] * b[0] + b[1] * b[1]) + (b[2] * b[2] + b[3] * b[3]);
              ss += __shfl_xor(ss, 16); ss += __shfl_xor(ss, 32);
              if (fq == 0) __hip_atomic_fetch_add(rsq + row, ss, __ATOMIC_RELAXED, __HIP_MEMORY_SCOPE_AGENT); }
        } else if (wc == 0) {
#pragma unroll
          for (int ai = 0; ai < 2; ++ai)
#pragma unroll
            for (int m = 0; m < 4; ++m) { const int row = row0 + ai * HALF + m * 16; const f32x4 a = acc[ai][bj][m][0], b = acc[ai][bj][m][1];
              const f32x4 cs = *(const f32x4*)(rope + (size_t)row * 32 + 4 * fq), sn = *(const f32x4*)(rope + (size_t)row * 32 + 16 + 4 * fq);
              f32x4 oa, ob;
              oa[0] = a[0] * cs[0] - a[1] * sn[0]; oa[1] = a[1] * cs[0] + a[0] * sn[0]; oa[2] = a[2] * cs[1] - a[3] * sn[1]; oa[3] = a[3] * cs[1] + a[2] * sn[1];
              ob[0] = b[0] * cs[2] - b[1] * sn[2]; ob[1] = b[1] * cs[2] + b[0] * sn[2]; ob[2] = b[2] * cs[3] - b[3] * sn[3]; ob[3] = b[3] * cs[3] + b[2] * sn[3];
              *(u32x4*)(KR + (size_t)row * 32 + 8 * fq) = pack8(oa, ob); }
        }
      }
    }
  }
};
struct EpiQ { static constexpr bool PERM = true; bf16_t* Q; const float* rsq; const float* rope;
  __device__ __forceinline__ void operator()(const Acc& acc, const Unit& u, int wr, int wc, int fr, int fq) const {
    const int row0 = u.pm * BM + wr * 64 + fr;
#pragma unroll
    for (int ai = 0; ai < 2; ++ai)
#pragma unroll
      for (int m = 0; m < 4; ++m) { const unsigned row = (unsigned)(row0 + ai * HALF + m * 16); const float rs = rsqrtf(rsq[row] * (1.0f / QLR) + NORM_EPS);
#pragma unroll
        for (int bj = 0; bj < 2; ++bj) { const unsigned c0 = (unsigned)(u.pn * BM + bj * HALF + wc * 32 + 8 * fq), d = c0 % 96u;
          f32x4 a = acc[ai][bj][m][0] * rs, b = acc[ai][bj][m][1] * rs;
          if (d >= 64u) { const unsigned j0 = (d - 64u) >> 1; const f32x4 cs = *(const f32x4*)(rope + (row * 32u + j0)), sn = *(const f32x4*)(rope + (row * 32u + 16u + j0));
            f32x4 oa, ob;
            oa[0] = a[0] * cs[0] - a[1] * sn[0]; oa[1] = a[1] * cs[0] + a[0] * sn[0]; oa[2] = a[2] * cs[1] - a[3] * sn[1]; oa[3] = a[3] * cs[1] + a[2] * sn[1];
            ob[0] = b[0] * cs[2] - b[1] * sn[2]; ob[1] = b[1] * cs[2] + b[0] * sn[2]; ob[2] = b[2] * cs[3] - b[3] * sn[3]; ob[3] = b[3] * cs[3] + b[2] * sn[3];
            a = oa; b = ob; }
          *(u32x4*)(Q + (row * (unsigned)NQ + c0)) = pack8(a, b);
          asm volatile("" ::: "memory"); } }
  }
};
struct EpiKV { static constexpr bool PERM = true; bf16_t* KV; const float* rsq;
  __device__ __forceinline__ void operator()(const Acc& acc, const Unit& u, int wr, int wc, int fr, int fq) const {
    const int row0 = u.pm * BM + wr * 64 + fr;
#pragma unroll
    for (int ai = 0; ai < 2; ++ai)
#pragma unroll
      for (int m = 0; m < 4; ++m) { const int row = row0 + ai * HALF + m * 16; const float rs = rsqrtf(rsq[row] * (1.0f / KVLR) + NORM_EPS);
#pragma unroll
        for (int bj = 0; bj < 2; ++bj) { const int c0 = u.pn * BM + bj * HALF + wc * 32 + 8 * fq;
          *(u32x4*)(KV + (size_t)row * NKV + c0) = pack8(acc[ai][bj][m][0] * rs, acc[ai][bj][m][1] * rs); } }
  }
};
template <bool ADD, int GOFF> struct EpiMerge { static constexpr bool PERM = true; bf16_t* YM; const bf16_t* G;
  __device__ __forceinline__ void operator()(const Acc& acc, const Unit& u, int wr, int wc, int fr, int fq) const {
    const int row0 = u.pm * BM + wr * 64 + fr;
#pragma unroll
    for (int ai = 0; ai < 2; ++ai)
#pragma unroll
      for (int m = 0; m < 4; ++m) { const int row = row0 + ai * HALF + m * 16;
#pragma unroll
        for (int bj = 0; bj < 2; ++bj) { const int c0 = u.pn * BM + bj * HALF + wc * 32 + 8 * fq;
          const u32x4 gw = *(const u32x4*)(G + (size_t)row * 2048 + GOFF + c0);
          f32x4 a = acc[ai][bj][m][0], b = acc[ai][bj][m][1];
#ifndef DBG_NOGATE
          a[0] *= bf_lo(gw.x); a[1] *= bf_hi(gw.x); a[2] *= bf_lo(gw.y); a[3] *= bf_hi(gw.y); b[0] *= bf_lo(gw.z); b[1] *= bf_hi(gw.z); b[2] *= bf_lo(gw.w); b[3] *= bf_hi(gw.w);
#else
          a[0] += 1e-30f * bf_lo(gw.x);
#endif
          bf16_t* p = YM + (size_t)row * DM + c0;
          if (ADD) { const u32x4 t = *(const u32x4*)p;
            a[0] += bf_lo(t.x); a[1] += bf_hi(t.x); a[2] += bf_lo(t.y); a[3] += bf_hi(t.y); b[0] += bf_lo(t.z); b[1] += bf_hi(t.z); b[2] += bf_lo(t.w); b[3] += bf_hi(t.w); }
          *(u32x4*)p = pack8(a, b); } }
  }
};
}

namespace attn {
constexpr int SHM_V = 64 * 64 * 2, SHM_K = 64 * 256, LDS_BYTES = 2 * SHM_V + 2 * SHM_K + 8 * 64 * 4;
constexpr float THRL = 11.5f;
#define KSWZ(row, colB) ((row) * 256 + ((colB) ^ (((row) & 7) << 4)))
__device__ __forceinline__ int crow(int r, int hi) { return (r & 3) + 8 * (r >> 2) + 4 * hi; }
typedef short v4i16_t __attribute__((ext_vector_type(4)));
__device__ __forceinline__ s16x4 vtr(const LAS unsigned char* p) { return __builtin_bit_cast(s16x4, __builtin_amdgcn_ds_read_tr16_b64_v4i16((LAS v4i16_t*)p)); }
__device__ __forceinline__ int swap23(int k) { return (k & ~0xC) | ((k & 4) << 1) | ((k & 8) >> 1); }
__device__ __forceinline__ int v_rd_base(int lane) { return ((lane & 3) << 3) | (((lane >> 2) & 3) << 6) | (((lane >> 4) & 1) << 5) | (((lane >> 5) & 1) << 8); }
template <int NB> __device__ __forceinline__ int t_st(int k, int n) { const int kk = swap23(k); return ((kk >> 3) * NB + (n >> 5)) * 512 + ((kk & 7) * 32 + (n & 31)) * 2; }
template <int NB> __device__ __forceinline__ bf16x8 t_frag(const LAS unsigned char* base, int ks, int nb) {
  const s16x4 l = vtr(base + nb * 512 + ks * (1024 * NB)), h = vtr(base + nb * 512 + ks * (1024 * NB) + 512 * NB);
  return (bf16x8){l[0], l[1], l[2], l[3], h[0], h[1], h[2], h[3]};
}
template <int NB> __device__ __forceinline__ int t_stn(int k, int n) { return ((k >> 3) * NB + (n >> 5)) * 512 + ((k & 7) * 32 + (n & 31)) * 2; }
template <bool FIRST> __device__ __forceinline__ float partialSM(f32x16& p0, f32x16& p1, float& mhat, f32x16& negm) {
  float a = fmaxf(fmaxf(p0[0], p0[1]), p0[2]), b = fmaxf(fmaxf(p1[0], p1[1]), p1[2]);
#pragma unroll
  for (int r = 3; r < 15; r += 2) { a = fmaxf(fmaxf(a, p0[r]), p0[r + 1]); b = fmaxf(fmaxf(b, p1[r]), p1[r + 1]); }
  float pmax = fmaxf(fmaxf(a, b), fmaxf(p0[15], p1[15]));
  { auto rr = __builtin_amdgcn_permlane32_swap(__float_as_uint(pmax), __float_as_uint(pmax), false, false);
    pmax = fmaxf(__uint_as_float(rr[0]), __uint_as_float(rr[1])); }
  float alpha = 1.f;
  if (FIRST || !__builtin_expect(__all(pmax <= THRL), 1)) {
    const float dl = FIRST ? pmax : fmaxf(pmax, 0.f);
    mhat += dl;
#pragma unroll
    for (int r = 0; r < 16; ++r) { p0[r] -= dl; p1[r] -= dl; negm[r] = -mhat; }
    if (!FIRST) alpha = __builtin_amdgcn_exp2f(-dl);
  }
#pragma unroll
  for (int r = 0; r < 16; ++r) p0[r] = __builtin_amdgcn_exp2f(p0[r]);
  return alpha;
}
__device__ __forceinline__ void finishSM(f32x16& p0, f32x16& p1, bf16x8& pa0, bf16x8& pa1, bf16x8& pa2, bf16x8& pa3) {
#pragma unroll
  for (int r = 0; r < 16; ++r) p1[r] = __builtin_amdgcn_exp2f(p1[r]);
#define PK8(P, BASE, OUT) do { u32x4 w = {cvt_pk_bf16(P[BASE + 0], P[BASE + 1]), cvt_pk_bf16(P[BASE + 2], P[BASE + 3]), cvt_pk_bf16(P[BASE + 4], P[BASE + 5]), cvt_pk_bf16(P[BASE + 6], P[BASE + 7])}; \
    OUT = __builtin_bit_cast(bf16x8, w); } while (0)
  PK8(p0, 0, pa0); PK8(p0, 8, pa1); PK8(p1, 0, pa2); PK8(p1, 8, pa3);
#undef PK8
}
__device__ __forceinline__ void qkt(f32x16& p0, f32x16& p1, const LAS unsigned char* Ks, const bf16x8* qr, const f32x16& negm, int r32, int hi) {
#pragma unroll
  for (int d0 = 0; d0 < 6; ++d0) { const int cb = (d0 * 16 + hi * 8) * 2;
    const bf16x8 b0 = *(const LAS bf16x8*)(Ks + KSWZ(r32, cb));
    const bf16x8 b1 = *(const LAS bf16x8*)(Ks + KSWZ(32 + r32, cb));
    if (d0 == 0) { p0 = __builtin_amdgcn_mfma_f32_32x32x16_bf16(b0, qr[0], negm, 0, 0, 0); p1 = __builtin_amdgcn_mfma_f32_32x32x16_bf16(b1, qr[0], negm, 0, 0, 0); }
    else { p0 = __builtin_amdgcn_mfma_f32_32x32x16_bf16(b0, qr[d0], p0, 0, 0, 0); p1 = __builtin_amdgcn_mfma_f32_32x32x16_bf16(b1, qr[d0], p1, 0, 0, 0); } }
}
__device__ __forceinline__ void pv2(f32x16* o, f32x16& ol, const LAS unsigned char* vb, bf16x8 pa0, bf16x8 pa1, bf16x8 pa2, bf16x8 pa3) {
  const bf16x8 ones = {0x3F80, 0x3F80, 0x3F80, 0x3F80, 0x3F80, 0x3F80, 0x3F80, 0x3F80};
#pragma unroll
  for (int d0 = 0; d0 < 2; ++d0) {
    const bf16x8 v0 = t_frag<2>(vb, 0, d0), v1 = t_frag<2>(vb, 1, d0), v2 = t_frag<2>(vb, 2, d0), v3 = t_frag<2>(vb, 3, d0);
    o[d0] = __builtin_amdgcn_mfma_f32_32x32x16_bf16(pa0, v0, o[d0], 0, 0, 0);
    o[d0] = __builtin_amdgcn_mfma_f32_32x32x16_bf16(pa1, v1, o[d0], 0, 0, 0);
    o[d0] = __builtin_amdgcn_mfma_f32_32x32x16_bf16(pa2, v2, o[d0], 0, 0, 0);
    o[d0] = __builtin_amdgcn_mfma_f32_32x32x16_bf16(pa3, v3, o[d0], 0, 0, 0);
  }
  ol = __builtin_amdgcn_mfma_f32_32x32x16_bf16(pa0, ones, ol, 0, 0, 0);
  ol = __builtin_amdgcn_mfma_f32_32x32x16_bf16(pa1, ones, ol, 0, 0, 0);
  ol = __builtin_amdgcn_mfma_f32_32x32x16_bf16(pa2, ones, ol, 0, 0, 0);
  ol = __builtin_amdgcn_mfma_f32_32x32x16_bf16(pa3, ones, ol, 0, 0, 0);
}
__device__ __forceinline__ unsigned f2bf(float f) { unsigned u = __float_as_uint(f); return (u + 0x7fffu + ((u >> 16) & 1u)) >> 16; }

__device__ __forceinline__ void attn_unit(int b, int h, int qb, const bf16_t* Q, const bf16_t* KV, const bf16_t* KR, bf16_t* O, LAS unsigned char* lds, const int wid) {
  const int lane = fresh_lane(), tid = wid * 64 + lane, r32 = lane & 31, hi = lane >> 5;
  LAS unsigned char* V_lds = lds; LAS unsigned char* K_lds = lds + 2 * SHM_V;
  LAS float* ws = (LAS float*)(lds + 2 * SHM_V + 2 * SHM_K) + wid * 64; LAS float* li_l = ws; LAS float* al_l = ws + 32;
  float mhat = 0.f; f32x16 o[2] = {}; f32x16 ol = {}; f32x16 negm = {}; bf16x8 qr[6];
  const size_t tok0 = (size_t)b * SEQ;
  const bf16_t* Qw = Q + (tok0 + qb * 256 + wid * 32 + r32) * NQ + h * 96 + hi * 8;
#pragma unroll
  for (int d0 = 0; d0 < 6; ++d0) qr[d0] = *(const bf16x8*)(Qw + d0 * 16);
  const int srow = tid >> 3, sch = tid & 7;
  const bf16_t* kp = KV + (tok0 + srow) * NKV + h * 128 + sch * 8; const bf16_t* vp = kp + 64; const bf16_t* rp = KR + (tok0 + srow) * 32 + sch * 4;
  const int kst = KSWZ(srow, sch * 16), vst = t_stn<2>(srow, sch * 8), rst = KSWZ(srow, 128 + (sch >> 1) * 16) + (sch & 1) * 8;
  const LAS unsigned char* vb0 = V_lds + v_rd_base(lane);
  bf16x8 ksA, vsA, ksB, vsB; u32x2 rsA, rsB;
#define SLOAD(S, k0) do { ks##S = *(const bf16x8*)(kp + (size_t)(k0) * NKV); vs##S = *(const bf16x8*)(vp + (size_t)(k0) * NKV); rs##S = *(const u32x2*)(rp + (size_t)(k0) * 32); } while (0)
#define SWRITE(bf, S) do { *(LAS bf16x8*)(K_lds + (bf) * SHM_K + kst) = ks##S; *(LAS bf16x8*)(V_lds + (bf) * SHM_V + vst) = vs##S; *(LAS u32x2*)(K_lds + (bf) * SHM_K + rst) = rs##S; } while (0)
#define SWAIT() asm volatile("s_waitcnt vmcnt(3)" ::: "memory")
#define RESC(a) do { if (__any((a) != 1.f)) { if (hi == 0) al_l[r32] = (a); LDS_WAIT(); \
    _Pragma("unroll") for (int r = 0; r < 16; ++r) { const float f_ = al_l[crow(r, hi)]; o[0][r] *= f_; o[1][r] *= f_; ol[r] *= f_; } } } while (0)
#define SBAR() __builtin_amdgcn_sched_barrier(0)
  f32x16 pA0, pA1, pB0, pB1; float alpha; constexpr int NT = SEQ / 64;
  int ka[4];
#pragma unroll
  for (int j = 0; j < 4; ++j) ka[j] = KSWZ(r32, j * 32 + hi * 16);
  const bf16x8 ones = {0x3F80, 0x3F80, 0x3F80, 0x3F80, 0x3F80, 0x3F80, 0x3F80, 0x3F80};
  bf16x8 kfA0, kfA1, kfB0, kfB1, kfC0, kfC1, vf0, vf1, vf2, vf3, wf0, wf1, wf2, wf3; u32x4 pw0, pw1, pw2, pw3;
#define KRD(S, d0, KB) do { kf##S##0 = *(const LAS bf16x8*)((KB) + ka[(d0) & 3] + ((d0) >> 2) * 128); kf##S##1 = *(const LAS bf16x8*)((KB) + ka[(d0) & 3] + ((d0) >> 2) * 128 + 8192); } while (0)
#define MF(A, B, C) __builtin_amdgcn_mfma_f32_32x32x16_bf16(A, B, C, 0, 0, 0)
#define PKW(P, B) (u32x4){cvt_pk_bf16(P[B], P[B + 1]), cvt_pk_bf16(P[B + 2], P[B + 3]), cvt_pk_bf16(P[B + 4], P[B + 5]), cvt_pk_bf16(P[B + 6], P[B + 7])}
#define PAF(k) __builtin_bit_cast(bf16x8, pw##k)
#define PIN(x) asm volatile("" : "+v"(x))
#define EX3(X, B) do { X[B] = __builtin_amdgcn_exp2f(X[B]); X[B + 1] = __builtin_amdgcn_exp2f(X[B + 1]); X[B + 2] = __builtin_amdgcn_exp2f(X[B + 2]); PIN(X); } while (0)
#define EX2(X, B) do { X[B] = __builtin_amdgcn_exp2f(X[B]); X[B + 1] = __builtin_amdgcn_exp2f(X[B + 1]); PIN(X); } while (0)
#define PHASE_A(C0, C1, P0, P1, KB, VB, PREV) do { \
    KRD(A, 0, KB); KRD(B, 1, KB); SBAR(); \
    C0 = MF(kfA0, qr[0], negm); if (PREV) vf0 = t_frag<2>(VB, 0, 0); SBAR(); \
    C1 = MF(kfA1, qr[0], negm); KRD(C, 2, KB); SBAR(); \
    C0 = MF(kfB0, qr[1], C0); if (PREV) vf1 = t_frag<2>(VB, 1, 0); SBAR(); \
    C1 = MF(kfB1, qr[1], C1); KRD(A, 3, KB); SBAR(); \
    C0 = MF(kfC0, qr[2], C0); if (PREV) { vf2 = t_frag<2>(VB, 2, 0); pw0 = PKW(P0, 0); PIN(pw0); } SBAR(); \
    C1 = MF(kfC1, qr[2], C1); KRD(B, 4, KB); SBAR(); \
    C0 = MF(kfA0, qr[3], C0); if (PREV) { vf3 = t_frag<2>(VB, 3, 0); pw1 = PKW(P0, 8); PIN(pw1); } SBAR(); \
    C1 = MF(kfA1, qr[3], C1); KRD(C, 5, KB); SBAR(); \
    C0 = MF(kfB0, qr[4], C0); if (PREV) { pw2 = PKW(P1, 0); PIN(pw2); } SBAR(); \
    C1 = MF(kfB1, qr[4], C1); SBAR(); \
    C0 = MF(kfC0, qr[5], C0); if (PREV) { pw3 = PKW(P1, 8); PIN(pw3); } SBAR(); \
    C1 = MF(kfC1, qr[5], C1); SBAR(); } while (0)
#define DECIDE(C0, C1, FIRST) do { \
    float a_ = fmaxf(fmaxf(C0[0], C0[1]), C0[2]), b_ = fmaxf(fmaxf(C1[0], C1[1]), C1[2]); \
    _Pragma("unroll") for (int r = 3; r < 15; r += 2) { a_ = fmaxf(fmaxf(a_, C0[r]), C0[r + 1]); b_ = fmaxf(fmaxf(b_, C1[r]), C1[r + 1]); } \
    float pmax = fmaxf(fmaxf(a_, b_), fmaxf(C0[15], C1[15])); \
    { auto rr = __builtin_amdgcn_permlane32_swap(__float_as_uint(pmax), __float_as_uint(pmax), false, false); pmax = fmaxf(__uint_as_float(rr[0]), __uint_as_float(rr[1])); } \
    alpha = 1.f; \
    if ((FIRST) || !__builtin_expect(__all(pmax <= THRL), 1)) { const float dl = (FIRST) ? pmax : fmaxf(pmax, 0.f); mhat += dl; \
      _Pragma("unroll") for (int r = 0; r < 16; ++r) { C0[r] -= dl; C1[r] -= dl; negm[r] = -mhat; } \
      if (!(FIRST)) alpha = __builtin_amdgcn_exp2f(-dl); } SBAR(); } while (0)
#define PHASE_B(C0, C1, VB) do { \
    o[0] = MF(PAF(0), vf0, o[0]); EX3(C0, 0); wf0 = t_frag<2>(VB, 0, 1); SBAR(); \
    o[0] = MF(PAF(1), vf1, o[0]); EX3(C0, 3); wf1 = t_frag<2>(VB, 1, 1); SBAR(); \
    o[0] = MF(PAF(2), vf2, o[0]); EX3(C0, 6); wf2 = t_frag<2>(VB, 2, 1); SBAR(); \
    o[0] = MF(PAF(3), vf3, o[0]); EX3(C0, 9); wf3 = t_frag<2>(VB, 3, 1); SBAR(); \
    ol = MF(PAF(0), ones, ol); EX3(C0, 12); SBAR(); \
    ol = MF(PAF(1), ones, ol); C0[15] = __builtin_amdgcn_exp2f(C0[15]); PIN(C0); EX2(C1, 0); SBAR(); \
    ol = MF(PAF(2), ones, ol); EX3(C1, 2); SBAR(); \
    ol = MF(PAF(3), ones, ol); EX3(C1, 5); SBAR(); \
    o[1] = MF(PAF(0), wf0, o[1]); EX2(C1, 8); SBAR(); \
    o[1] = MF(PAF(1), wf1, o[1]); EX2(C1, 10); SBAR(); \
    o[1] = MF(PAF(2), wf2, o[1]); EX2(C1, 12); SBAR(); \
    o[1] = MF(PAF(3), wf3, o[1]); EX2(C1, 14); SBAR(); } while (0)
#define EXALL(C0, C1) do { _Pragma("unroll") for (int r = 0; r < 16; ++r) { C0[r] = __builtin_amdgcn_exp2f(C0[r]); C1[r] = __builtin_amdgcn_exp2f(C1[r]); } } while (0)
  const LAS unsigned char* Kb0 = K_lds; const LAS unsigned char* Kb1 = K_lds + SHM_K; const LAS unsigned char* Vb0 = vb0; const LAS unsigned char* Vb1 = vb0 + SHM_V;
  SLOAD(A, 0); VM_WAIT(); SWRITE(0, A); __syncthreads();
  PHASE_A(pA0, pA1, pA0, pA1, Kb0, Vb0, false); DECIDE(pA0, pA1, true); EXALL(pA0, pA1);
  SLOAD(B, 64); SLOAD(A, 128);
  SWAIT(); SWRITE(1, B); __syncthreads();
  for (int j = 1; j + 1 < NT; j += 2) {
    SBAR(); PHASE_A(pB0, pB1, pA0, pA1, Kb1, Vb0, true);
    SLOAD(B, (j + 2) * 64); SBAR();
    DECIDE(pB0, pB1, false); PHASE_B(pB0, pB1, Vb0);
    __syncthreads(); SWAIT(); SWRITE(0, A);
    RESC(alpha); __syncthreads();
    SBAR(); PHASE_A(pA0, pA1, pB0, pB1, Kb0, Vb1, true);
    if (j + 3 < NT) SLOAD(A, (j + 3) * 64); SBAR();
    DECIDE(pA0, pA1, false); PHASE_B(pA0, pA1, Vb1);
    __syncthreads(); SWAIT(); SWRITE(1, B);
    RESC(alpha); __syncthreads();
  }
  SBAR(); PHASE_A(pB0, pB1, pA0, pA1, Kb1, Vb0, true);
  DECIDE(pB0, pB1, false); PHASE_B(pB0, pB1, Vb0);
  RESC(alpha);
  pw0 = PKW(pB0, 0); pw1 = PKW(pB0, 8); pw2 = PKW(pB1, 0); pw3 = PKW(pB1, 8);
  pv2(o, ol, Vb1, PAF(0), PAF(1), PAF(2), PAF(3));
#undef KRD
#undef MF
#undef PKW
#undef PAF
#undef EX3
#undef PIN
#undef EX2
#undef PHASE_A
#undef DECIDE
#undef PHASE_B
#undef EXALL
  float rli[16];
#pragma unroll
  for (int r = 0; r < 16; ++r) rli[r] = __builtin_amdgcn_rcpf(ol[r]);
  bf16_t* Ow = O + (tok0 + qb * 256 + wid * 32) * 512 + h * 64;
#pragma unroll
  for (int r = 0; r < 16; ++r) { const int orow = crow(r, hi);
#pragma unroll
    for (int d0 = 0; d0 < 2; ++d0) Ow[(size_t)orow * 512 + d0 * 32 + r32] = (bf16_t)f2bf(o[d0][r] * rli[r]); }
  VM_WAIT(); __syncthreads();
#undef SLOAD
#undef SWRITE
#undef SWAIT
#undef RESC
#undef SBAR
}
}

namespace fft {
using attn::crow; using attn::t_st; using attn::t_frag; using attn::v_rd_base; using attn::f2bf;
__device__ __forceinline__ int am64(int row, int k) { return row * 128 + ((((k >> 3) ^ (row & 7))) << 4) + (k & 7) * 2; }
__device__ __forceinline__ int am128(int row, int k) { return row * 256 + ((((k >> 3) ^ (row & 15))) << 4) + (k & 7) * 2; }
constexpr int T_OFF = 0, A_OFF = 65536, TWL_OFF = 65536 + 24576;
__device__ __forceinline__ void stage1(const bf16_t* V, bf16_t* Y, const bf16_t* c64  , const float* tw, LAS unsigned char* lds, int first, int stride, const int wid) {
  const int lane = fresh_lane(), tid = wid * 64 + lane, r32 = lane & 31, hi = lane >> 5;
  LAS unsigned char* T = lds + T_OFF; LAS unsigned char* A = lds + A_OFF; LAS f32x2* twl = (LAS f32x2*)(lds + TWL_OFF);
#pragma unroll
  for (int i = 0; i < 3; ++i) { const int idx = tid + 512 * i, mi = idx >> 9, ch = idx & 511, row = ch >> 3, kc = ch & 7;
    *(LAS u32x4*)(A + mi * 8192 + am64(row, kc * 8)) = *(const u32x4*)(c64 + mi * 4096 + row * 64 + kc * 8); }
  u32x4 st[8];
#define F1_LOAD(u) do { const int b_ = (u) >> 8, b2_ = ((u) >> 1) & 127, hf_ = (u) & 1; \
    _Pragma("unroll") for (int i = 0; i < 8; ++i) { const int idx = tid + 512 * i, a = idx >> 6, n = (idx & 63) * 8; const int gcol = (n < 256) ? hf_ * 256 + n : 512 + hf_ * 256 + (n - 256); \
      st[i] = *(const u32x4*)(V + ((size_t)b_ * SEQ + 128 * a + b2_) * 1024 + gcol); } } while (0)
  int u = first; if (u >= 1024) return;
  F1_LOAD(u);
  for (;;) {
    const int b = u >> 8, b2 = (u >> 1) & 127, hf = u & 1;
#pragma unroll
    for (int i = 0; i < 8; ++i) { const int idx = tid + 512 * i, a = idx >> 6, n = (idx & 63) * 8; *(LAS u32x4*)(T + t_st<16>(a, n)) = st[i]; }
    if (tid < 64) twl[tid] = *(const f32x2*)(tw + ((size_t)tid * 128 + b2) * 2);
    __syncthreads();
    const int un = u + stride; if (un < 1024) F1_LOAD(un);
    const LAS unsigned char* tb = T + v_rd_base(lane);
    {
      asm volatile("" ::: "memory");
      const int nbr = wid, nbi = 8 + wid;
      f32x16 ar[2] = {}, ai[2] = {};
#pragma unroll
      for (int ks = 0; ks < 4; ++ks) {
        const bf16x8 Br = t_frag<16>(tb, ks, nbr), Bi = t_frag<16>(tb, ks, nbi);
#pragma unroll
        for (int mb = 0; mb < 2; ++mb) { const int off = am64(32 * mb + r32, 16 * ks + 8 * hi);
          const bf16x8 Ac = *(const LAS bf16x8*)(A + off), As = *(const LAS bf16x8*)(A + 8192 + off), An = *(const LAS bf16x8*)(A + 16384 + off);
          ar[mb] = __builtin_amdgcn_mfma_f32_32x32x16_bf16(Ac, Br, ar[mb], 0, 0, 0); ar[mb] = __builtin_amdgcn_mfma_f32_32x32x16_bf16(As, Bi, ar[mb], 0, 0, 0);
          ai[mb] = __builtin_amdgcn_mfma_f32_32x32x16_bf16(Ac, Bi, ai[mb], 0, 0, 0); ai[mb] = __builtin_amdgcn_mfma_f32_32x32x16_bf16(An, Br, ai[mb], 0, 0, 0); }
      }
      const int colr = hf * 256 + 32 * wid + r32;
#pragma unroll
      for (int mb = 0; mb < 2; ++mb)
#pragma unroll
        for (int r = 0; r < 16; ++r) { const int c = 32 * mb + crow(r, hi); const f32x2 t = twl[c]; const float yr = ar[mb][r], yi = ai[mb][r];
          bf16_t* dst = Y + (((size_t)b * 64 + c) * 128 + b2) * 1024 + colr;
          dst[0] = (bf16_t)f2bf(yr * t.x + yi * t.y); dst[512] = (bf16_t)f2bf(yi * t.x - yr * t.y); }
    }
    __syncthreads();
    if (un >= 1024) break; u = un;
  }
#undef F1_LOAD
}
__device__ __forceinline__ void stage2(const bf16_t* Y, bf16_t* F, const bf16_t* c128  , LAS unsigned char* lds, int first, int stride, const int wid) {
  const int lane = fresh_lane(), tid = wid * 64 + lane, r32 = lane & 31, hi = lane >> 5;
  LAS unsigned char* T = lds + T_OFF; LAS unsigned char* A = lds + A_OFF;
#pragma unroll
  for (int i = 0; i < 8; ++i) { const int idx = tid + 512 * i, mi = idx >> 11, ch = idx & 2047, row = ch >> 4, kc = ch & 15;
    *(LAS u32x4*)(A + mi * 32768 + am128(row, kc * 8)) = *(const u32x4*)(c128 + mi * 16384 + row * 128 + kc * 8); }
  u32x4 st[8];
#define F2_LOAD(u) do { const int b_ = (u) >> 8, c_ = ((u) >> 2) & 63, qt_ = (u) & 3; \
    _Pragma("unroll") for (int i = 0; i < 8; ++i) { const int idx = tid + 512 * i, row = idx >> 5, n = (idx & 31) * 8; const int gcol = (n < 128) ? qt_ * 128 + n : 512 + qt_ * 128 + (n - 128); \
      st[i] = *(const u32x4*)(Y + (((size_t)b_ * 64 + c_) * 128 + row) * 1024 + gcol); } } while (0)
  int u = first; if (u >= 1024) return;
  F2_LOAD(u);
  for (;;) {
    const int b = u >> 8, c = (u >> 2) & 63, qt = u & 3;
#pragma unroll
    for (int i = 0; i < 8; ++i) { const int idx = tid + 512 * i, row = idx >> 5, n = (idx & 31) * 8; *(LAS u32x4*)(T + t_st<8>(row, n)) = st[i]; }
    __syncthreads();
    const int un = u + stride; if (un < 1024) F2_LOAD(un);
    const LAS unsigned char* tb = T + v_rd_base(lane);
    const int nb = wid & 3, mh = wid >> 2;
    asm volatile("" ::: "memory");
    f32x16 acc[2] = {};
#pragma unroll
    for (int ks = 0; ks < 8; ++ks) {
      const bf16x8 Br = t_frag<8>(tb, ks, nb), Bi = t_frag<8>(tb, ks, 4 + nb);
#pragma unroll
      for (int mb = 0; mb < 2; ++mb) { const int off = am128(64 * mh + 32 * mb + r32, 16 * ks + 8 * hi);
        const bf16x8 Ac = *(const LAS bf16x8*)(A + off), As = *(const LAS bf16x8*)(A + 32768 + off);
        acc[mb] = __builtin_amdgcn_mfma_f32_32x32x16_bf16(Ac, Br, acc[mb], 0, 0, 0); acc[mb] = __builtin_amdgcn_mfma_f32_32x32x16_bf16(As, Bi, acc[mb], 0, 0, 0); }
    }
#pragma unroll
    for (int mb = 0; mb < 2; ++mb)
#pragma unroll
      for (int r = 0; r < 16; ++r) { const int d = 64 * mh + 32 * mb + crow(r, hi);
        F[((size_t)b * SEQ + c + 64 * d) * 512 + qt * 128 + 32 * nb + r32] = (bf16_t)f2bf(acc[mb][r]); }
    __syncthreads();
    if (un >= 1024) break; u = un;
  }
#undef F2_LOAD
}
}

#define XB_TMO      128
#define XB_XCNT(j)  (256  + 64 * (j))
#define XB_XSUB(j)  (1280 + 64 * (j))
#define XB_XGEN(j)  (2304 + 64 * (j))
#define XB_TOP      3328
#define XB_TOPGEN   3392
#define XCD_BAR_WORDS 3456
#define XB_SPIN_CAP (1u << 18)
__device__ __forceinline__ unsigned xb_ld(unsigned* p)              { return __hip_atomic_load(p, __ATOMIC_RELAXED, __HIP_MEMORY_SCOPE_AGENT); }
__device__ __forceinline__ unsigned xb_add(unsigned* p, unsigned v) { return __hip_atomic_fetch_add(p, v, __ATOMIC_RELAXED, __HIP_MEMORY_SCOPE_AGENT); }
__device__ __forceinline__ unsigned xb_xcc_id() { return (unsigned)__builtin_amdgcn_s_getreg((3 << 11) | 20) & 0xFu; }
#define XB_SPIN(cond, bar) do { unsigned _sp = 0; while (cond) { __builtin_amdgcn_s_sleep(1); \
    if ((++_sp & 255u) == 0u) { if (xb_ld(&(bar)[XB_TMO])) break; if (_sp > XB_SPIN_CAP) { atomicAdd(&(bar)[XB_TMO], 1u); break; } } } } while (0)
struct XcdBarrier { unsigned* bar; unsigned x; volatile LAS unsigned* st; };
__device__ __forceinline__ XcdBarrier xcd_barrier_post(unsigned* bar, volatile LAS unsigned* st) {
  XcdBarrier b; b.bar = bar; b.x = xb_xcc_id(); b.st = st;
  if (threadIdx.x == 0) (void)xb_add(&bar[XB_XCNT(b.x)], 1u);
  return b;
}
__device__ __forceinline__ void xcd_barrier_complete(unsigned* bar, unsigned x, unsigned& nloc, unsigned& nx) {
  const unsigned G = gridDim.x * gridDim.y * gridDim.z;
  unsigned sum, cnt, mine, sp = 0u;
  for (;;) {
    sum = 0u; cnt = 0u; mine = 0u;
#pragma unroll
    for (unsigned j = 0; j < 16; ++j) { const unsigned c = xb_ld(&bar[XB_XCNT(j)]); sum += c; cnt += (c > 0u) ? 1u : 0u; mine = (j == x) ? c : mine; }
    if (sum == G) break;
    __builtin_amdgcn_s_sleep(1);
    if ((++sp & 255u) == 0u) { if (xb_ld(&bar[XB_TMO])) break; if (sp > XB_SPIN_CAP) { atomicAdd(&bar[XB_TMO], 1u); break; } }
  }
  nloc = mine > 0u ? mine : 1u; nx = cnt > 0u ? cnt : 1u;
}
__device__ __forceinline__ void xcd_barrier(const XcdBarrier& b) {
  asm volatile("s_waitcnt vmcnt(0)" ::: "memory");
  __syncthreads();
  if (threadIdx.x == 0) {
    unsigned* bar = b.bar;
    __builtin_amdgcn_s_waitcnt(0);
    unsigned nloc = b.st[0], nx = b.st[1];
    if (nloc == 0u) { xcd_barrier_complete(bar, b.x, nloc, nx); b.st[0] = nloc; b.st[1] = nx; }
    const unsigned old = xb_add(&bar[XB_XSUB(b.x)], 1u);
    const unsigned gen = old / nloc;
    if (old + 1u == (gen + 1u) * nloc) {
      __builtin_amdgcn_fence(__ATOMIC_RELEASE, "agent");
      asm volatile("s_waitcnt vmcnt(0)" ::: "memory");
      const unsigned og = xb_add(&bar[XB_TOP], 1u);
      const unsigned tg = og / nx;
      if (og + 1u == (tg + 1u) * nx) xb_add(&bar[XB_TOPGEN], 1u);
      else XB_SPIN(xb_ld(&bar[XB_TOPGEN]) == tg, bar);
      __builtin_amdgcn_fence(__ATOMIC_ACQUIRE, "agent");
      xb_add(&bar[XB_XGEN(b.x)], 1u);
      asm volatile("s_waitcnt vmcnt(0)" ::: "memory");
    } else {
      XB_SPIN(xb_ld(&bar[XB_XGEN(b.x)]) == gen, bar);
      __builtin_amdgcn_fence(__ATOMIC_ACQUIRE, "agent");
      asm volatile("s_waitcnt vmcnt(0)" ::: "memory");
    }
  }
  __syncthreads();
}

constexpr int NWAVES = 8;
constexpr int RING_BYTES = 131072, LDSCTL_OFF = RING_BYTES, MISC_OFF = LDSCTL_OFF + 320, FOLD_OFF = RING_BYTES + 1024;
constexpr int LDS_BYTES = 147456;
struct Args { const float* in[23]; float* out; unsigned char* ws; int ph_lo, ph_hi; };
struct Frame {
  LAS unsigned char* lds; int wave, vcu, G;
  const float* const* in; float* out; unsigned char* ws;
};

__device__ __forceinline__ void p0_transpose_item(const float* W, int ldw, int k0, int n0, bf16_t* WT, int ldwt, int drow0, bool perm, const float* kscale, float cscale, LAS float* scr, int lane) {
#pragma unroll 8
  for (int i = 0; i < 32; ++i) { const int kk = 2 * i + (lane >> 5); float v = W[(size_t)(k0 + kk) * ldw + n0 + (lane & 31)]; if (kscale) v *= kscale[k0 + kk]; scr[kk * 33 + (lane & 31)] = v * cscale; }
  LDS_WAIT(); asm volatile("" ::: "memory");
  const int c = lane & 7;
#pragma unroll
  for (int j = 0; j < 4; ++j) { const int n = (lane >> 3) + 8 * j; const LAS float* s = scr + (8 * c) * 33 + n;
    u32x4 o; o.x = cvt_pk_bf16(s[0 * 33], s[1 * 33]); o.y = cvt_pk_bf16(s[2 * 33], s[3 * 33]); o.z = cvt_pk_bf16(s[4 * 33], s[5 * 33]); o.w = cvt_pk_bf16(s[6 * 33], s[7 * 33]);
    const int dr = drow0 + (perm ? (n < 16 ? 2 * n : 2 * (n - 16) + 1) : n);
    *(u32x4*)(WT + (size_t)dr * ldwt + k0 + 8 * c) = o; }
  LDS_WAIT(); asm volatile("" ::: "memory");
}
constexpr int I_GU = 16 * 88, I_DN = 44 * 32, I_WIN = 16 * 85, I_WQ = 6 * 24, I_WKV = 4 * 32, I_WF = 8 * 32, I_WO = 16 * 32;
constexpr int NTRANS = 4 * I_GU + 2 * I_DN + I_WIN + I_WQ + I_WKV + 2 * I_WF + I_WO;
constexpr int NMODI = 144 * 32;
__device__ __forceinline__ void p0_trans_dispatch(const Frame& F, int r, LAS float* scr) {
  unsigned char* ws = F.ws; const int lane = fresh_lane();
  if (r < 4 * I_GU) { const int j = r / I_GU, it = r % I_GU, kb = it / 88, nb = it % 88, n0 = nb * 32;
    const float* W = j == 0 ? F.in[6] : j == 1 ? F.in[7] : j == 2 ? F.in[19] : F.in[20]; bf16_t* WT = (bf16_t*)(ws + (j < 2 ? WS_WGU1 : WS_WGU2));
    p0_transpose_item(W, DFF, kb * 64, n0, WT, DM, (n0 >> 7) * 256 + (j & 1) * 128 + (n0 & 127), false, nullptr, 1.f, scr, lane); return; }
  r -= 4 * I_GU;
  if (r < 2 * I_DN) { const int j = r / I_DN, it = r % I_DN, kb = it / 32, nb = it % 32;
    p0_transpose_item(j ? F.in[21] : F.in[8], DM, kb * 64, nb * 32, (bf16_t*)(ws + (j ? WS_WD2 : WS_WD1)), DFF, nb * 32, false, nullptr, 1.f, scr, lane); return; }
  r -= 2 * I_DN;
  if (r < I_WIN) { const int kb = r / 85, nb = r % 85, n0 = 512 + nb * 32; int dr; bool perm = false;
    if (n0 < 896) dr = 3072 + (n0 - 512); else if (n0 < 1152) dr = 3456 + (n0 - 896); else if (n0 < 1184) { dr = 3712; perm = true; } else dr = 1024 + (n0 - 1184);
    p0_transpose_item(F.in[10], 3232, kb * 64, n0, (bf16_t*)(ws + WS_WIN), DM, dr, perm, nullptr, 1.f, scr, lane); return; }
  r -= I_WIN;
  if (r < I_WQ) { const int kb = r / 24, nb = r % 24, n0 = nb * 32;
    p0_transpose_item(F.in[12], NQ, kb * 64, n0, (bf16_t*)(ws + WS_WQ), QLR, n0, (n0 % 96) == 64, F.in[11], SCQ, scr, lane); return; }
  r -= I_WQ;
  if (r < I_WKV) { const int kb = r / 32, nb = r % 32;
    p0_transpose_item(F.in[14], NKV, kb * 64, nb * 32, (bf16_t*)(ws + WS_WKV), KVLR, nb * 32, false, F.in[13], 1.f, scr, lane); return; }
  r -= I_WKV;
  if (r < 2 * I_WF) { const int j = r / I_WF, it = r % I_WF, kb = it / 32, nb = it % 32;
    p0_transpose_item(j ? F.in[16] : F.in[15], DM, kb * 64, nb * 32, (bf16_t*)(ws + (j ? WS_WM : WS_WF)), 512, nb * 32, false, nullptr, 1.f, scr, lane); return; }
  r -= 2 * I_WF;
  { const int kb = r / 32, nb = r % 32;
    p0_transpose_item(F.in[17], DM, kb * 64, nb * 32, (bf16_t*)(ws + WS_WO), DM, nb * 32, false, nullptr, 1.f, scr, lane); }
}
__device__ __forceinline__ void p0_mod_item(const Frame& F, int it) {
  const int nb = it % 144, kc = it / 144, n = nb * 64 + fresh_lane(); const float* cin = F.in[1]; const float* W = F.in[3] + (size_t)(kc * 32) * NADA + n;
  float acc[4] = {0.f, 0.f, 0.f, 0.f};
#pragma unroll 8
  for (int kk = 0; kk < 32; ++kk) { const float w = W[(size_t)kk * NADA];
#pragma unroll
    for (int b = 0; b < 4; ++b) { const float cv = cin[b * DM + kc * 32 + kk]; acc[b] += cv * fast_sigmoid(cv) * w; } }
  float* mod = (float*)(F.ws + OFF_MOD);
#pragma unroll
  for (int b = 0; b < 4; ++b) { float v = acc[b]; if (kc == 0) v += F.in[4][n]; __hip_atomic_fetch_add(mod + b * NADA + n, v, __ATOMIC_RELAXED, __HIP_MEMORY_SCOPE_AGENT); }
}
__device__ __forceinline__ void p0_fold_item(const Frame& F, int it) {
  LAS float* tile = (LAS float*)(F.lds + FOLD_OFF); LAS float* cosT = tile + 2048;
  const int kc = it >> 2, g = it & 3, k0 = kc * 16, tid = F.wave * 64 + fresh_lane();
  { const int idx = tid * 4, kk = idx >> 7, c = idx & 127; *(LAS f32x4*)(tile + idx) = *(const f32x4*)(F.in[10] + (size_t)(k0 + kk) * 3232 + g * 128 + c); }
  if (tid < 128) cosT[tid] = __builtin_amdgcn_cosf((float)tid * (1.0f / 128.0f)) * 0.08838834764831845f;
  __syncthreads();
  const int n = tid & 255, ri = n >> 7, m = n & 127, kh = tid >> 8;
  float acc[8] = {0.f, 0.f, 0.f, 0.f, 0.f, 0.f, 0.f, 0.f};
  for (int c = 0; c < 128; ++c) { const int idx = (m * c) & 127; const float tv = ri ? -cosT[(idx - 32) & 127] : cosT[idx];
#pragma unroll
    for (int q = 0; q < 8; ++q) acc[q] += tile[(kh * 8 + q) * 128 + c] * tv; }
  u32x4 o; o.x = cvt_pk_bf16(acc[0], acc[1]); o.y = cvt_pk_bf16(acc[2], acc[3]); o.z = cvt_pk_bf16(acc[4], acc[5]); o.w = cvt_pk_bf16(acc[6], acc[7]);
  *(u32x4*)((bf16_t*)(F.ws + WS_WIN) + (size_t)(ri * 512 + g * 128 + m) * DM + k0 + kh * 8) = o;
  __syncthreads();
}
__device__ __forceinline__ void p0_prologue(const Frame& F) {
  unsigned char* ws = F.ws;
  for (int it = blockIdx.x; it < 256; it += F.G) p0_fold_item(F, it);
  LAS float* scr = (LAS float*)(F.lds + F.wave * 16384);
  const int gw = F.vcu * NWAVES + F.wave, NGW = F.G * NWAVES;
  for (int it = gw; it < NMODI; it += NGW) p0_mod_item(F, it);
  for (int it = gw; it < NTRANS; it += NGW) p0_trans_dispatch(F, it, scr);
  const int gt = blockIdx.x * 512 + F.wave * 64 + fresh_lane(), NGT = F.G * 512;
  { const int* pos = (const int*)F.in[2]; float* rope = (float*)(ws + WS_ROPE);
    for (int e = gt; e < MTOK * 16; e += NGT) { const int tok = e >> 4, j = e & 15;
      const double c4 = (j & 3) == 0 ? 1.0 : (j & 3) == 1 ? 0.5623413251903491 : (j & 3) == 2 ? 0.31622776601683794 : 0.1778279410038923;
      const double p10 = (j >> 2) == 0 ? 1.0 : (j >> 2) == 1 ? 0.1 : (j >> 2) == 2 ? 0.01 : 0.001;
      const float inv = (float)(c4 * p10); const float ang = (float)pos[tok] * inv;
      double t = (double)ang * 0.15915494309189535; t -= __builtin_floor(t); const float tf = (float)t;
      rope[(size_t)tok * 32 + j] = __builtin_amdgcn_cosf(tf); rope[(size_t)tok * 32 + 16 + j] = __builtin_amdgcn_sinf(tf); } }
  { float* tw = (float*)(ws + WS_TW);
    for (int e = gt; e < 64 * 128; e += NGT) { const int c = e >> 7, b2 = e & 127; const float t = (float)((c * b2) & 8191) * (1.0f / 8192.0f);
      tw[2 * e] = __builtin_amdgcn_cosf(t); tw[2 * e + 1] = __builtin_amdgcn_sinf(t); } }
  { bf16_t* c64 = (bf16_t*)(ws + WS_C64);
    for (int e = gt; e < 4096; e += NGT) { const int c = e >> 6, a = e & 63; const float t = (float)((c * a) & 63) * (1.0f / 64.0f);
      const float cs = __builtin_amdgcn_cosf(t) * 0.125f, sn = __builtin_amdgcn_sinf(t) * 0.125f;
      c64[e] = (bf16_t)attn::f2bf(cs); c64[4096 + e] = (bf16_t)attn::f2bf(sn); c64[8192 + e] = (bf16_t)attn::f2bf(-sn); } }
  { bf16_t* c128 = (bf16_t*)(ws + WS_C128);
    for (int e = gt; e < 16384; e += NGT) { const int d = e >> 7, b2 = e & 127; const float t = (float)((d * b2) & 127) * (1.0f / 128.0f);
      c128[e] = (bf16_t)attn::f2bf(__builtin_amdgcn_cosf(t) * 0.08838834764831845f); c128[16384 + e] = (bf16_t)attn::f2bf(__builtin_amdgcn_sinf(t) * 0.08838834764831845f); } }
  { u32x4* z = (u32x4*)((bf16_t*)(ws + WS_WIN) + (size_t)3744 * DM);
    for (int e = gt; e < 96 * DM / 8; e += NGT) z[e] = (u32x4){0u, 0u, 0u, 0u}; }
}
__device__ __forceinline__ void norm_mod_phase(const Frame& F, const float* x, const float* g, const float* mod_shift, const float* mod_scale, bf16_t* H) {
  const int gw = F.vcu * NWAVES + F.wave, NGW = F.G * NWAVES, lane = fresh_lane();
  for (int ch = gw; ch < MTOK / 16; ch += NGW) {
    const int row0 = ch * 16, b = row0 / SEQ;
    f32x4 av[4], bv[4];
#pragma unroll
    for (int j = 0; j < 4; ++j) { const int col = 4 * lane + 256 * j; const f32x4 gg = *(const f32x4*)(g + col), sc = *(const f32x4*)(mod_scale + (size_t)b * NADA + col);
      av[j] = gg * (1.0f + sc); bv[j] = *(const f32x4*)(mod_shift + (size_t)b * NADA + col); }
    for (int r = 0; r < 16; ++r) {
      const f32x4* xr = (const f32x4*)(x + (size_t)(row0 + r) * DM) + lane; f32x4 v[4]; float s = 0.f;
#pragma unroll
      for (int j = 0; j < 4; ++j) { v[j] = xr[64 * j]; s += (v[j][0] * v[j][0] + v[j][1] * v[j][1]) + (v[j][2] * v[j][2] + v[j][3] * v[j][3]); }
      const float rs = rsqrtf(wave_sum(s) * (1.0f / DM) + NORM_EPS);
      u32x2* o8 = (u32x2*)(H + (size_t)(row0 + r) * DM) + lane;
#pragma unroll
      for (int j = 0; j < 4; ++j) { const f32x4 y = v[j] * rs * av[j] + bv[j]; u32x2 w; w.x = cvt_pk_bf16(y[0], y[1]); w.y = cvt_pk_bf16(y[2], y[3]); o8[64 * j] = w; }
    }
  }
}
__device__ __forceinline__ void final_norm_phase(const Frame& F, float* x, const float* g) {
  const int gw = F.vcu * NWAVES + F.wave, NGW = F.G * NWAVES, lane = fresh_lane();
  f32x4 gv[4];
#pragma unroll
  for (int j = 0; j < 4; ++j) gv[j] = *(const f32x4*)(g + 4 * lane + 256 * j);
  for (int row = gw; row < MTOK; row += NGW) {
    f32x4* xr = (f32x4*)(x + (size_t)row * DM) + lane; f32x4 v[4]; float s = 0.f;
#pragma unroll
    for (int j = 0; j < 4; ++j) { v[j] = xr[64 * j]; s += (v[j][0] * v[j][0] + v[j][1] * v[j][1]) + (v[j][2] * v[j][2] + v[j][3] * v[j][3]); }
    const float rs = rsqrtf(wave_sum(s) * (1.0f / DM) + NORM_EPS);
#pragma unroll
    for (int j = 0; j < 4; ++j) xr[64 * j] = v[j] * rs * gv[j];
  }
}

constexpr int NPHASE = 14;
__global__ void __launch_bounds__(NWAVES * 64, 2) mk_fwd(Args args) {
  extern __shared__ __attribute__((aligned(16))) unsigned char lds_raw[];
  Frame F;
  F.lds = (LAS unsigned char*)lds_raw; F.wave = __builtin_amdgcn_readfirstlane(threadIdx.x >> 6);
  F.G = gridDim.x; { const int bx = blockIdx.x; F.vcu = (F.G % 8 == 0) ? (bx % 8) * (F.G / 8) + bx / 8 : bx; }
  F.in = args.in; F.out = args.out; F.ws = args.ws;
  unsigned char* ws = args.ws;
  for (int u = threadIdx.x; u < (LDS_BYTES - LDSCTL_OFF) / 4; u += NWAVES * 64) ((LAS unsigned*)(F.lds + LDSCTL_OFF))[u] = 0u;
  __syncthreads();
#if MK_SINGLE
  XcdBarrier bar = xcd_barrier_post((unsigned*)(ws + WS_CTL) + CW_BAR, (volatile LAS unsigned*)(F.lds + MISC_OFF) + 8);
#define GRID_BAR() xcd_barrier(bar)
#else
#define GRID_BAR() do {} while (0)
#endif
  const int lo = args.ph_lo, hi = args.ph_hi;
#ifndef PH_MASK
#define PH_MASK 0xFFFF
#endif
#define IN(k) (((PH_MASK >> (k)) & 1) && lo <= (k) && (k) < hi)
#define SEAM(k) do { if (IN(k) && IN((k) + 1)) GRID_BAR(); } while (0)
  const float* mod = (const float*)(ws + OFF_MOD);
  float* rsq_q = (float*)(ws + OFF_RSQQ); float* rsq_kv = (float*)(ws + OFF_RSQKV);
  const float* rope = (const float*)(ws + WS_ROPE);
  bf16_t* H = (bf16_t*)(ws + WS_H); bf16_t* ACT = (bf16_t*)(ws + WS_BIG);
  bf16_t* Vb = (bf16_t*)(ws + WS_V); bf16_t* Yb = (bf16_t*)(ws + WS_Y); bf16_t* Fb = (bf16_t*)(ws + WS_F); bf16_t* ZL = (bf16_t*)(ws + WS_ZL); bf16_t* Ob = (bf16_t*)(ws + WS_O);
  bf16_t* Qb = (bf16_t*)(ws + WS_H); bf16_t* KVb = (bf16_t*)(ws + WS_KV); bf16_t* KRb = (bf16_t*)(ws + WS_KR); bf16_t* GT = (bf16_t*)(ws + WS_GATES); bf16_t* YM = (bf16_t*)(ws + WS_H);
  const int cu = (int)blockIdx.x;

  if (IN(0)) { p0_prologue(F); } SEAM(0);
#ifndef DUP
#define DUP 0
#endif
  if (IN(1)) { for (int rep = 0; rep < 1 + ((DUP >> 0) & 1); ++rep) norm_mod_phase(F, F.in[0], F.in[5], mod + 0 * DM, mod + 1 * DM, H); } SEAM(1);
  if (IN(2)) { for (int rep = 0; rep < 1 + ((DUP >> 1) & 1); ++rep) { pg8::Gemm g{H, (const bf16_t*)(ws + WS_WGU1), MTOK, 2 * DFF, DM, DM, DM}; pg8::StaticOrder S; S.init(MTOK, 2 * DFF, F.G, cu);
    pg8::EpiSwiglu E{ACT}; pg8::gemm_phase(F.lds, g, S, E, F.wave); } } SEAM(2);
  if (IN(3)) { pg8::Gemm g{ACT, (const bf16_t*)(ws + WS_WD1), MTOK, DM, DFF, DFF, DFF}; pg8::StaticOrder S; S.init(MTOK, DM, F.G, cu);
    pg8::EpiResid E{F.in[0], F.out, mod + 2 * DM, 0.5f}; pg8::gemm_phase(F.lds, g, S, E, F.wave); } SEAM(3);
  if (IN(4)) { norm_mod_phase(F, F.out, F.in[9], mod + 3 * DM, mod + 4 * DM, H); } SEAM(4);
  if (IN(5)) { pg8::Gemm g{H, (const bf16_t*)(ws + WS_WIN), MTOK, NWIN, DM, DM, DM}; pg8::StaticOrder S; S.init(MTOK, NWIN, F.G, cu);
    pg8::EpiWin E{Vb, GT, ZL, KRb, rsq_q, rsq_kv, rope}; pg8::gemm_phase(F.lds, g, S, E, F.wave); } SEAM(5);
#ifndef P6_PART
#define P6_PART 7
#endif
  if (IN(6)) {
    if (P6_PART & 1) { pg8::Gemm g{ZL, (const bf16_t*)(ws + WS_WQ), MTOK, NQ, QLR, ZLW, QLR}; pg8::StaticOrder S; S.init(MTOK, NQ, F.G, cu);
      pg8::EpiQ E{Qb, rsq_q, rope}; pg8::gemm_phase(F.lds, g, S, E, F.wave); }
    if (P6_PART & 2) { pg8::Gemm g{ZL + QLR, (const bf16_t*)(ws + WS_WKV), MTOK, NKV, KVLR, ZLW, KVLR}; pg8::StaticOrder S; S.init(MTOK, NKV, F.G, F.G - 1 - cu);
      pg8::EpiKV E{KVb, rsq_kv}; pg8::gemm_phase(F.lds, g, S, E, F.wave); }
    if (P6_PART & 4) for (int rep = 0; rep < 1 + ((DUP >> 2) & 1); ++rep) fft::stage1(Vb, Yb, (const bf16_t*)(ws + WS_C64), (const float*)(ws + WS_TW), F.lds, F.vcu, F.G, F.wave);
  } SEAM(6);
  if (IN(7)) {
    for (int rep = 0; rep < 1 + ((DUP >> 3) & 1); ++rep) fft::stage2(Yb, Fb, (const bf16_t*)(ws + WS_C128), F.lds, F.vcu, F.G, F.wave);
    { const int xl = F.vcu >> 5, qb = F.vcu & 31;
      for (int i = 0; i < 4 * (1 + ((DUP >> 4) & 1)); ++i) { const int bh = xl + 8 * (i & 3); if (F.G == 256) attn::attn_unit(bh >> 3, bh & 7, qb, Qb, KVb, KRb, Ob, F.lds, F.wave); }
      if (F.G != 256) for (int uu = cu; uu < 1024; uu += F.G) attn::attn_unit(uu >> 8, (uu >> 5) & 7, uu & 31, Qb, KVb, KRb, Ob, F.lds, F.wave); }
  } SEAM(7);
#ifndef MERGE_PART
#define MERGE_PART 3
#endif
  if (IN(8)) {
#ifndef DBG_SRC
#define DBG_SRC 0
#endif
    if (MERGE_PART & 1) { pg8::Gemm g{DBG_SRC == 1 ? Vb : DBG_SRC == 2 ? Yb : Fb, (const bf16_t*)(ws + WS_WF), MTOK, DM, 512, DBG_SRC ? 1024 : 512, 512}; pg8::StaticOrder S; S.init(MTOK, DM, F.G, cu);
      pg8::EpiMerge<false, 0> E{YM, GT}; pg8::gemm_phase(F.lds, g, S, E, F.wave); }
    if (MERGE_PART == 3) { pg8::Gemm g{Ob, (const bf16_t*)(ws + WS_WM), MTOK, DM, 512, 512, 512}; pg8::StaticOrder S; S.init(MTOK, DM, F.G, cu);
      pg8::EpiMerge<true, 1024> E{YM, GT}; pg8::gemm_phase(F.lds, g, S, E, F.wave); }
    if (MERGE_PART == 2) { pg8::Gemm g{Ob, (const bf16_t*)(ws + WS_WM), MTOK, DM, 512, 512, 512}; pg8::StaticOrder S; S.init(MTOK, DM, F.G, cu);
      pg8::EpiMerge<false, 1024> E{YM, GT}; pg8::gemm_phase(F.lds, g, S, E, F.wave); }
  } SEAM(8);
  if (IN(9)) { pg8::Gemm g{YM, (const bf16_t*)(ws + WS_WO), MTOK, DM, DM, DM, DM}; pg8::StaticOrder S; S.init(MTOK, DM, F.G, cu);
    pg8::EpiResid E{F.out, F.out, mod + 5 * DM, 1.0f}; pg8::gemm_phase(F.lds, g, S, E, F.wave); } SEAM(9);
  if (IN(10)) { norm_mod_phase(F, F.out, F.in[18], mod + 6 * DM, mod + 7 * DM, H); } SEAM(10);
  if (IN(11)) { pg8::Gemm g{H, (const bf16_t*)(ws + WS_WGU2), MTOK, 2 * DFF, DM, DM, DM}; pg8::StaticOrder S; S.init(MTOK, 2 * DFF, F.G, cu);
    pg8::EpiSwiglu E{ACT}; pg8::gemm_phase(F.lds, g, S, E, F.wave); } SEAM(11);
  if (IN(12)) { pg8::Gemm g{ACT, (const bf16_t*)(ws + WS_WD2), MTOK, DM, DFF, DFF, DFF}; pg8::StaticOrder S; S.init(MTOK, DM, F.G, cu);
    pg8::EpiResid E{F.out, F.out, mod + 8 * DM, 0.5f}; pg8::gemm_phase(F.lds, g, S, E, F.wave); } SEAM(12);
  if (IN(13)) { final_norm_phase(F, F.out, F.in[22]); }
#undef IN
#undef SEAM
}

extern "C" void kernel_launch(void* const* d_in, const int* in_sizes, int n_in, void* d_out, int out_size, void* d_ws, size_t ws_size, hipStream_t stream) {
  static int grid = 0;
  if (grid == 0) {
    if (n_in != 23 || in_sizes[0] != MTOK * DM || out_size != MTOK * DM || ws_size < WS_END) {
      fprintf(stderr, "kernel_launch: unexpected shapes n_in %d in0 %d out %d ws %zu (need >= %zu)\n", n_in, n_in > 0 ? in_sizes[0] : -1, out_size, ws_size, (size_t)WS_END); grid = -1; return; }
    int dev = 0, cus = 0;
    if (hipGetDevice(&dev) != hipSuccess || hipDeviceGetAttribute(&cus, hipDeviceAttributeMultiprocessorCount, dev) != hipSuccess) { grid = -1; return; }
    if (hipFuncSetAttribute((const void*)mk_fwd, hipFuncAttributeMaxDynamicSharedMemorySize, LDS_BYTES) != hipSuccess) { fprintf(stderr, "kernel_launch: hipFuncSetAttribute failed\n"); grid = -1; return; }
    grid = cus;
  }
  if (grid < 0) return;
  (void)hipMemsetAsync((char*)d_ws + WS_CTL, 0, CTL_ZERO_BYTES, stream);
  Args a{};
  for (int i = 0; i < 23; ++i) a.in[i] = (const float*)d_in[i];
  a.out = (float*)d_out; a.ws = (unsigned char*)d_ws;
#if MK_SINGLE
  a.ph_lo = 0; a.ph_hi = NPHASE;
  hipLaunchKernelGGL(mk_fwd, dim3(grid), dim3(NWAVES * 64), LDS_BYTES, stream, a);
#else
  for (int p = 0; p < NPHASE; ++p) { a.ph_lo = p; a.ph_hi = p + 1; hipLaunchKernelGGL(mk_fwd, dim3(grid), dim3(NWAVES * 64), LDS_BYTES, stream, a); }
#endif
}
```

```cpp
#include <hip/hip_runtime.h>
#include <cstdio>
#include <cstdint>

#define LAS __attribute__((address_space(3)))
#define GAS __attribute__((address_space(1)))
typedef unsigned short bf16_t;
typedef short bf16x8 __attribute__((ext_vector_type(8)));
typedef short s16x4 __attribute__((ext_vector_type(4)));
typedef float f32x4 __attribute__((ext_vector_type(4)));
typedef float f32x2 __attribute__((ext_vector_type(2)));
typedef float f32x16 __attribute__((ext_vector_type(16)));
typedef unsigned u32x4 __attribute__((ext_vector_type(4)));
typedef unsigned u32x2 __attribute__((ext_vector_type(2)));

#ifndef MK_SINGLE
#define MK_SINGLE 1
#endif

constexpr int BATCH = 4, SEQ = 8192, DM = 1024, MTOK = BATCH * SEQ, DFF = 2816, NADA = 9 * DM;
constexpr int NWIN = 3840;
constexpr int QLR = 384, KVLR = 256, NQ = 768, NKV = 1024, ZLW = 768;
constexpr float NORM_EPS = 1e-6f;
constexpr float SCQ = 0.10206207261596575f * 1.4426950408889634f;

constexpr size_t MiB = 1u << 20;
constexpr size_t WS_CTL = 0, CTL_ZERO_BYTES = 2 * MiB;
constexpr size_t OFF_MOD = 256 * 1024, OFF_RSQQ = 512 * 1024, OFF_RSQKV = 640 * 1024;
constexpr size_t WS_ROPE = 2 * MiB;
constexpr size_t WS_TW = 6 * MiB;
constexpr size_t WS_C64 = 6 * MiB + 64 * 1024, WS_S64 = WS_C64 + 8192, WS_NS64 = WS_S64 + 8192;
constexpr size_t WS_C128 = 6 * MiB + 128 * 1024, WS_S128 = WS_C128 + 32768;
constexpr size_t WS_WGU1 = 8 * MiB, WS_WD1 = 19 * MiB, WS_WGU2 = 25 * MiB, WS_WD2 = 36 * MiB, WS_WIN = 42 * MiB;
constexpr size_t WS_WQ = 50 * MiB, WS_WKV = 51 * MiB, WS_WF = 52 * MiB, WS_WM = 53 * MiB, WS_WO = 54 * MiB;
constexpr size_t WS_H = 64 * MiB;
constexpr size_t WS_KV = 128 * MiB;
constexpr size_t WS_GATES = 192 * MiB;
constexpr size_t WS_KR = 320 * MiB;
constexpr size_t WS_BIG = 322 * MiB;
constexpr size_t WS_V = WS_BIG, WS_F = WS_BIG, WS_Y = WS_BIG + 64 * MiB, WS_ZL = WS_BIG + 128 * MiB, WS_O = WS_ZL;
constexpr size_t WS_END = 498 * MiB;
constexpr int CW_BAR = 4096;

typedef __bf16 bf16x2_t __attribute__((ext_vector_type(2)));
__device__ __forceinline__ unsigned cvt_pk_bf16(float lo, float hi) { f32x2 v = {lo, hi}; bf16x2_t b = __builtin_convertvector(v, bf16x2_t); return __builtin_bit_cast(unsigned, b); }
__device__ __forceinline__ float bf_lo(unsigned w) { return __uint_as_float(w << 16); }
__device__ __forceinline__ float bf_hi(unsigned w) { return __uint_as_float(w & 0xffff0000u); }
__device__ __forceinline__ u32x4 pack8(f32x4 a, f32x4 b) { u32x4 w; w.x = cvt_pk_bf16(a[0], a[1]); w.y = cvt_pk_bf16(a[2], a[3]); w.z = cvt_pk_bf16(b[0], b[1]); w.w = cvt_pk_bf16(b[2], b[3]); return w; }
__device__ __forceinline__ float fast_sigmoid(float v) { return __builtin_amdgcn_rcpf(1.0f + __builtin_amdgcn_exp2f(-1.4426950408889634f * v)); }
__device__ __forceinline__ float wave_sum(float v) {
#pragma unroll
  for (int o = 1; o < 64; o <<= 1) v += __shfl_xor(v, o);
  return v;
}
__device__ __forceinline__ int fresh_lane() { int l; asm volatile("v_mbcnt_lo_u32_b32 %0, -1, 0\n\tv_mbcnt_hi_u32_b32 %0, -1, %0" : "=v"(l)); return l; }
#define LDS_WAIT() asm volatile("s_waitcnt lgkmcnt(0)" ::: "memory")
#define VM_WAIT() asm volatile("s_waitcnt vmcnt(0)" ::: "memory")

namespace pg8 {
constexpr int BM = 256, BK = 64, HALF = 128, HTB = HALF * BK * 2, STAGE_BYTES = 8 * HTB, NXCD = 8, WGM = 8;
__host__ __device__ __forceinline__ int lds_byte(int r, int c) { const int st = (r >> 4) * 2 + (c >> 5), rr = r & 15, cc = c & 31, ob = rr * 64 + cc * 2; return st * 1024 + (ob ^ (((ob >> 9) & 1) << 5)); }
__host__ __device__ __forceinline__ void stage_rc(int b, int& R, int& C) { const int st = b / 1024, sb = b % 1024, swz = sb ^ (((sb >> 9) & 1) << 5); R = (st >> 1) * 16 + swz / 64; C = (st & 1) * 32 + (swz % 64) / 2; }
__host__ __device__ __forceinline__ int perm32(int rho) { const int n = rho >> 4, i = rho & 15; return 8 * (i >> 2) + 4 * n + (i & 3); }
struct Unit { int pm, pn; };
struct Gemm { const bf16_t* A; const bf16_t* Bt; int M, N, K, lda, ldb; };
struct StaticOrder {
  int nM, nN, nwg, G, c;
  __host__ __device__ void init(int M, int N, int G_, int c_) { nM = M / BM; nN = N / BM; nwg = nM * nN; G = G_; c = c_; }
  __host__ __device__ bool next(int i, Unit& u) const {
    const long L = (long)i * G + c; if (L >= nwg) return false;
    int wgid = (int)L; { const int q = nwg / NXCD, r = nwg % NXCD, xcd = wgid % NXCD, off = wgid / NXCD; wgid = (xcd < r ? xcd * (q + 1) : r * (q + 1) + (xcd - r) * q) + off; }
    const int nig = WGM * nN, gid = wgid / nig, fm = gid * WGM, gsz = (nM - fm) < WGM ? (nM - fm) : WGM;
    u.pm = fm + ((wgid % nig) % gsz); u.pn = (wgid % nig) / gsz; return true;
  }
};
template <class Epi, class Sched, bool ALIGN_EPI = true, bool SP2 = true>
__device__ __forceinline__ void gemm_phase(LAS unsigned char* lds, const Gemm g, const Sched& S, const Epi& E, const int wid) {
  const int lane0 = fresh_lane();
  const int tid = wid * 64 + lane0, wr = wid >> 2, wc = wid & 3, fr = lane0 & 15, fq = lane0 >> 4;
  const int K = g.K, nt = K / BK;
  unsigned voffA[2], voffB[2];
#pragma unroll
  for (int i = 0; i < 2; ++i) { int R, C; stage_rc(tid * 16 + i * 8192, R, C); const int Rb = Epi::PERM ? ((R & ~31) + perm32(R & 31)) : R;
    voffA[i] = (unsigned)(R * g.lda + C) * 2u; voffB[i] = (unsigned)(Rb * g.ldb + C) * 2u; }
  const size_t kstep = (size_t)(BK * 2);
  const size_t hstepA = (size_t)HALF * g.lda * 2, hstepB = (size_t)HALF * g.ldb * 2;
  const size_t tstepA = 2 * hstepA, tstepB = 2 * hstepB;
  const unsigned ldsw = (unsigned)wid * 1024u;
  const int aoff = lds_byte(wr * 64 + fr, fq * 8), boff = lds_byte(wc * 32 + fr, fq * 8);
#define PG8_SA(b, h) (((b) * 2 + (h)) * HTB)
#define PG8_SB(b, h) ((4 + (b) * 2 + (h)) * HTB)
#define PG8_STAGE(bufoff, gbase, voff) do { _Pragma("unroll") for (int _i = 0; _i < 2; ++_i) \
    __builtin_amdgcn_global_load_lds((const unsigned*)((const char*)(gbase) + (voff)[_i]), (LAS unsigned*)(lds + (bufoff) + ldsw + _i * 8192), 16, 0, 0); } while (0)
#define PG8_LDA(dst, b, h) do { _Pragma("unroll") for (int m = 0; m < 4; ++m) _Pragma("unroll") for (int k = 0; k < 2; ++k) dst[m][k] = *(const LAS bf16x8*)(lds + PG8_SA(b, h) + aoff + m * 2048 + k * 1024); } while (0)
#define PG8_LDB(dst, b, h) do { _Pragma("unroll") for (int n = 0; n < 2; ++n) _Pragma("unroll") for (int k = 0; k < 2; ++k) dst[n][k] = *(const LAS bf16x8*)(lds + PG8_SB(b, h) + boff + n * 2048 + k * 1024); } while (0)
#define PG8_MMA(ai, bj, At, Bt) do { __builtin_amdgcn_s_setprio(1); _Pragma("unroll") for (int m = 0; m < 4; ++m) _Pragma("unroll") for (int n = 0; n < 2; ++n) _Pragma("unroll") for (int k = 0; k < 2; ++k) \
    acc[ai][bj][m][n] = __builtin_amdgcn_mfma_f32_16x16x32_bf16(Bt[n][k], At[m][k], acc[ai][bj][m][n], 0, 0, 0); __builtin_amdgcn_s_setprio(0); } while (0)
#define PG8_WAIT_V(n) asm volatile("s_waitcnt vmcnt(" #n ")" ::: "memory")
#define PG8_WAIT_L(n) asm volatile("s_waitcnt lgkmcnt(" #n ")" ::: "memory")
#define PG8_BAR __builtin_amdgcn_s_barrier()
#define PG8_SCHED __builtin_amdgcn_sched_barrier(0)
  Unit cur, nxt; int ui = 0;
  if (!S.next(0, cur)) return;
  f32x4 acc[2][2][4][2];
#pragma unroll
  for (int a = 0; a < 2; ++a)
#pragma unroll
    for (int b = 0; b < 2; ++b)
#pragma unroll
      for (int m = 0; m < 4; ++m)
#pragma unroll
        for (int n = 0; n < 2; ++n) acc[a][b][m][n] = (f32x4){0.f, 0.f, 0.f, 0.f};
  bf16x8 At[4][2], B0[2][2], B1[2][2];
  const char* cA = (const char*)g.A + (size_t)cur.pm * tstepA; const char* cB = (const char*)g.Bt + (size_t)cur.pn * tstepB;
  if constexpr (SP2) {
    PG8_STAGE(PG8_SB(0, 0), cB, voffB); PG8_STAGE(PG8_SB(0, 1), cB + hstepB, voffB); PG8_STAGE(PG8_SA(0, 0), cA, voffA); PG8_STAGE(PG8_SA(0, 1), cA + hstepA, voffA);
    if (wr == 1) PG8_BAR;
    PG8_WAIT_V(2); PG8_BAR;
    PG8_STAGE(PG8_SB(1, 0), cB + kstep, voffB); PG8_STAGE(PG8_SA(1, 0), cA + kstep, voffA); PG8_STAGE(PG8_SB(1, 1), cB + hstepB + kstep, voffB);
    PG8_WAIT_V(6); PG8_BAR;
  } else {
    PG8_STAGE(PG8_SB(0, 0), cB, voffB); PG8_STAGE(PG8_SA(0, 0), cA, voffA); PG8_STAGE(PG8_SB(0, 1), cB + hstepB, voffB); PG8_STAGE(PG8_SA(0, 1), cA + hstepA, voffA);
    if (wr == 1) PG8_BAR;
    PG8_WAIT_V(4); PG8_BAR;
    PG8_STAGE(PG8_SB(1, 0), cB + kstep, voffB); PG8_STAGE(PG8_SA(1, 0), cA + kstep, voffA); PG8_STAGE(PG8_SB(1, 1), cB + hstepB + kstep, voffB);
    PG8_WAIT_V(6); PG8_BAR;
  }
  for (;;) {
    const bool has_next = S.next(ui + 1, nxt);
    const char* nA = has_next ? (const char*)g.A + (size_t)nxt.pm * tstepA : cA; const char* nB = has_next ? (const char*)g.Bt + (size_t)nxt.pn * tstepB : cB;
    for (int t = 0; t < nt; t += 2) {
      const bool last = (t == nt - 2);
      const char* a1 = cA + (size_t)(t + 1) * kstep;
      const char* a2 = last ? nA : cA + (size_t)(t + 2) * kstep; const char* b2 = last ? nB : cB + (size_t)(t + 2) * kstep;
      const char* a3 = a2 + kstep; const char* b3 = b2 + kstep;
      if constexpr (SP2) {
        PG8_LDB(B0, 0, 0); PG8_LDB(B1, 0, 1); PG8_SCHED; PG8_LDA(At, 0, 0); PG8_STAGE(PG8_SA(1, 1), a1 + hstepA, voffA);
        PG8_WAIT_V(8); PG8_WAIT_L(0); PG8_BAR; PG8_MMA(0, 0, At, B0); PG8_MMA(0, 1, At, B1); PG8_BAR; PG8_SCHED;
        PG8_LDA(At, 0, 1); PG8_STAGE(PG8_SB(0, 0), b2, voffB); PG8_STAGE(PG8_SB(0, 1), b2 + hstepB, voffB); PG8_STAGE(PG8_SA(0, 0), a2, voffA);
        PG8_WAIT_V(8); PG8_WAIT_L(0); PG8_BAR; PG8_MMA(1, 0, At, B0); PG8_MMA(1, 1, At, B1); PG8_BAR; PG8_SCHED;
        PG8_LDB(B0, 1, 0); PG8_LDB(B1, 1, 1); PG8_SCHED; PG8_LDA(At, 1, 0); PG8_STAGE(PG8_SA(0, 1), a2 + hstepA, voffA);
        PG8_WAIT_V(8); PG8_WAIT_L(0); PG8_BAR; PG8_MMA(0, 0, At, B0); PG8_MMA(0, 1, At, B1); PG8_BAR; PG8_SCHED;
        PG8_LDA(At, 1, 1); PG8_STAGE(PG8_SB(1, 0), b3, voffB); PG8_STAGE(PG8_SB(1, 1), b3 + hstepB, voffB); PG8_STAGE(PG8_SA(1, 0), a3, voffA);
        PG8_WAIT_V(8); PG8_WAIT_L(0); PG8_BAR; PG8_MMA(1, 0, At, B0); PG8_MMA(1, 1, At, B1); PG8_BAR; PG8_SCHED;
      } else {
        PG8_LDB(B0, 0, 0); PG8_SCHED; PG8_LDA(At, 0, 0); PG8_STAGE(PG8_SA(1, 1), a1 + hstepA, voffA);
        PG8_WAIT_L(8); PG8_BAR; PG8_WAIT_L(0); PG8_MMA(0, 0, At, B0); PG8_BAR; PG8_SCHED;
        PG8_LDB(B1, 0, 1); PG8_STAGE(PG8_SB(0, 0), b2, voffB);
        PG8_BAR; PG8_WAIT_L(0); PG8_MMA(0, 1, At, B1); PG8_BAR;
        PG8_LDA(At, 0, 1); PG8_STAGE(PG8_SA(0, 0), a2, voffA);
        PG8_BAR; PG8_WAIT_L(0); PG8_MMA(1, 0, At, B0); PG8_BAR; PG8_SCHED;
        PG8_STAGE(PG8_SB(0, 1), b2 + hstepB, voffB);
        PG8_WAIT_V(6); PG8_BAR; PG8_MMA(1, 1, At, B1); PG8_BAR;
        PG8_LDB(B0, 1, 0); PG8_SCHED; PG8_LDA(At, 1, 0); PG8_STAGE(PG8_SA(0, 1), a2 + hstepA, voffA);
        PG8_WAIT_L(8); PG8_BAR; PG8_WAIT_L(0); PG8_MMA(0, 0, At, B0); PG8_BAR; PG8_SCHED;
        PG8_LDB(B1, 1, 1); PG8_STAGE(PG8_SB(1, 0), b3, voffB);
        PG8_BAR; PG8_WAIT_L(0); PG8_MMA(0, 1, At, B1); PG8_BAR;
        PG8_LDA(At, 1, 1); PG8_STAGE(PG8_SA(1, 0), a3, voffA);
        PG8_BAR; PG8_WAIT_L(0); PG8_MMA(1, 0, At, B0); PG8_BAR; PG8_SCHED;
        PG8_STAGE(PG8_SB(1, 1), b3 + hstepB, voffB);
        PG8_WAIT_V(6); PG8_BAR; PG8_MMA(1, 1, At, B1); PG8_BAR;
      }
    }
    if constexpr (ALIGN_EPI) { if (wr == 0) PG8_BAR; }
    { const int le = fresh_lane(); E(acc, cur, wr, wc, le & 15, le >> 4); }
    if (!has_next) break;
#pragma unroll
    for (int a = 0; a < 2; ++a)
#pragma unroll
      for (int b = 0; b < 2; ++b)
#pragma unroll
        for (int m = 0; m < 4; ++m)
#pragma unroll
          for (int n = 0; n < 2; ++n) acc[a][b][m][n] = (f32x4){0.f, 0.f, 0.f, 0.f};
    cur = nxt; cA = nA; cB = nB; ++ui;
    if constexpr (ALIGN_EPI) { if (wr == 1) PG8_BAR; }
  }
  PG8_WAIT_V(0);
  if constexpr (!ALIGN_EPI) { if (wr == 0) PG8_BAR; }
  PG8_BAR;
#undef PG8_SA
#undef PG8_SB
#undef PG8_STAGE
#undef PG8_LDA
#undef PG8_LDB
#undef PG8_MMA
#undef PG8_WAIT_V
#undef PG8_WAIT_L
#undef PG8_BAR
#undef PG8_SCHED
}

typedef f32x4 Acc[2][2][4][2];
struct EpiSwiglu { static constexpr bool PERM = true; bf16_t* O;
  __device__ __forceinline__ void operator()(const Acc& acc, const Unit& u, int wr, int wc, int fr, int fq) const {
    const int row0 = u.pm * BM + wr * 64 + fr, col0 = u.pn * 128 + wc * 32 + 8 * fq;
#pragma unroll
    for (int ai = 0; ai < 2; ++ai)
#pragma unroll
      for (int m = 0; m < 4; ++m) { bf16_t* p = O + (size_t)(row0 + ai * HALF + m * 16) * DFF + col0; f32x4 r[2];
#pragma unroll
        for (int n = 0; n < 2; ++n)
#pragma unroll
          for (int j = 0; j < 4; ++j) { const float gv = acc[ai][0][m][n][j], uv = acc[ai][1][m][n][j]; r[n][j] = gv * fast_sigmoid(gv) * uv; }
        *(u32x4*)p = pack8(r[0], r[1]); }
  }
};
struct EpiResid { static constexpr bool PERM = false; const float* base; float* out; const float* gvec; float coef;
  __device__ __forceinline__ void operator()(const Acc& acc, const Unit& u, int wr, int wc, int fr, int fq) const {
    const int row0 = u.pm * BM + wr * 64 + fr, col0 = u.pn * BM + wc * 32 + 4 * fq; const float* g = gvec + (size_t)(u.pm >> 5) * NADA;
    f32x4 gv[2][2];
#pragma unroll
    for (int bj = 0; bj < 2; ++bj)
#pragma unroll
      for (int n = 0; n < 2; ++n) gv[bj][n] = *(const f32x4*)(g + col0 + bj * HALF + n * 16) * coef;
#pragma unroll
    for (int ai = 0; ai < 2; ++ai)
#pragma unroll
      for (int m = 0; m < 4; ++m) { const size_t off = (size_t)(row0 + ai * HALF + m * 16) * DM + col0;
#pragma unroll
        for (int bj = 0; bj < 2; ++bj)
#pragma unroll
          for (int n = 0; n < 2; ++n) { const f32x4 b = *(const f32x4*)(base + off + bj * HALF + n * 16); *(f32x4*)(out + off + bj * HALF + n * 16) = b + gv[bj][n] * acc[ai][bj][m][n]; } }
  }
};
struct EpiWin { static constexpr bool PERM = true; bf16_t *V, *GATES, *ZL, *KR; float *rsq_q, *rsq_kv; const float* rope;
  __device__ __forceinline__ void operator()(const Acc& acc, const Unit& u, int wr, int wc, int fr, int fq) const {
    const int row0 = u.pm * BM + wr * 64 + fr, cw = wc * 32 + 8 * fq;
    if (u.pn < 4) {
#pragma unroll
      for (int ai = 0; ai < 2; ++ai)
#pragma unroll
        for (int m = 0; m < 4; ++m)
#pragma unroll
          for (int bj = 0; bj < 2; ++bj) *(u32x4*)(V + (size_t)(row0 + ai * HALF + m * 16) * 1024 + u.pn * 256 + bj * HALF + cw) = pack8(acc[ai][bj][m][0], acc[ai][bj][m][1]);
    } else if (u.pn < 12) {
#pragma unroll
      for (int ai = 0; ai < 2; ++ai)
#pragma unroll
        for (int m = 0; m < 4; ++m)
#pragma unroll
          for (int bj = 0; bj < 2; ++bj) { f32x4 a = acc[ai][bj][m][0], b = acc[ai][bj][m][1];
#pragma unroll
            for (int j = 0; j < 4; ++j) { a[j] = fast_sigmoid(a[j]); b[j] = fast_sigmoid(b[j]); }
            *(u32x4*)(GATES + (size_t)(row0 + ai * HALF + m * 16) * 2048 + (u.pn - 4) * 256 + bj * HALF + cw) = pack8(a, b); }
    } else {
#pragma unroll
      for (int bj = 0; bj < 2; ++bj) { const int zc0 = (u.pn - 12) * 256 + bj * HALF;
        if (zc0 < 640) { float* rsq = zc0 < 384 ? rsq_q : rsq_kv;
#pragma unroll
          for (int ai = 0; ai < 2; ++ai)
#pragma unroll
            for (int m = 0; m < 4; ++m) { const int row = row0 + ai * HALF + m * 16; const f32x4 a = acc[ai][bj][m][0], b = acc[ai][bj][m][1];
              *(u32x4*)(ZL + (size_t)row * ZLW + zc0 + cw) = pack8(a, b);
              float ss = (a[0] * a[0] + a[1] * a[1]) + (a[2] * a[2] + a[3] * a[3]) + (b[0] * b[0] + b[1] * b[1]) + (b[2] * b[2] + b[3] * b[3]);
              ss += __shfl_xor(ss, 16); ss += __shfl_xor(ss, 32);
              if (fq == 0) __hip_atomic_fetch_add(rsq + row, ss, __ATOMIC_RELAXED, __HIP_MEMORY_SCOPE_AGENT); }
        } else if (wc == 0) {
#pragma unroll
          for (int ai = 0; ai < 2; ++ai)
#pragma unroll
            for (int m = 0; m < 4; ++m) { const int row = row0 + ai * HALF + m * 16; const f32x4 a = acc[ai][bj][m][0], b = acc[ai][bj][m][1];
              const f32x4 cs = *(const f32x4*)(rope + (size_t)row * 32 + 4 * fq), sn = *(const f32x4*)(rope + (size_t)row * 32 + 16 + 4 * fq);
              f32x4 oa, ob;
              oa[0] = a[0] * cs[0] - a[1] * sn[0]; oa[1] = a[1] * cs[0] + a[0] * sn[0]; oa[2] = a[2] * cs[1] - a[3] * sn[1]; oa[3] = a[3] * cs[1] + a[2] * sn[1];
              ob[0] = b[0] * cs[2] - b[1] * sn[2]; ob[1] = b[1] * cs[2] + b[0] * sn[2]; ob[2] = b[2] * cs[3] - b[3] * sn[3]; ob[3] = b[3] * cs[3] + b[2] * sn[3];
              *(u32x4*)(KR + (size_t)row * 32 + 8 * fq) = pack8(oa, ob); }
        }
      }
    }
  }
};
struct EpiQ { static constexpr bool PERM = true; bf16_t* Q; const float* rsq; const float* rope;
  __device__ __forceinline__ void operator()(const Acc& acc, const Unit& u, int wr, int wc, int fr, int fq) const {
    const int row0 = u.pm * BM + wr * 64 + fr;
#pragma unroll
    for (int ai = 0; ai < 2; ++ai)
#pragma unroll
      for (int m = 0; m < 4; ++m) { const unsigned row = (unsigned)(row0 + ai * HALF + m * 16); const float rs = rsqrtf(rsq[row] * (1.0f / QLR) + NORM_EPS);
#pragma unroll
        for (int bj = 0; bj < 2; ++bj) { const unsigned c0 = (unsigned)(u.pn * BM + bj * HALF + wc * 32 + 8 * fq), d = c0 % 96u;
          f32x4 a = acc[ai][bj][m][0] * rs, b = acc[ai][bj][m][1] * rs;
          if (d >= 64u) { const unsigned j0 = (d - 64u) >> 1; const f32x4 cs = *(const f32x4*)(rope + (row * 32u + j0)), sn = *(const f32x4*)(rope + (row * 32u + 16u + j0));
            f32x4 oa, ob;
            oa[0] = a[0] * cs[0] - a[1] * sn[0]; oa[1] = a[1] * cs[0] + a[0] * sn[0]; oa[2] = a[2] * cs[1] - a[3] * sn[1]; oa[3] = a[3] * cs[1] + a[2] * sn[1];
            ob[0] = b[0] * cs[2] - b[1] * sn[2]; ob[1] = b[1] * cs[2] + b[0] * sn[2]; ob[2] = b[2] * cs[3] - b[3] * sn[3]; ob[3] = b[3] * cs[3] + b[2] * sn[3];
            a = oa; b = ob; }
          *(u32x4*)(Q + (row * (unsigned)NQ + c0)) = pack8(a, b);
          asm volatile("" ::: "memory"); } }
  }
};
struct EpiKV { static constexpr bool PERM = true; bf16_t* KV; const float* rsq;
  __device__ __forceinline__ void operator()(const Acc& acc, const Unit& u, int wr, int wc, int fr, int fq) const {
    const int row0 = u.pm * BM + wr * 64 + fr;
#pragma unroll
    for (int ai = 0; ai < 2; ++ai)
#pragma unroll
      for (int m = 0; m < 4; ++m) { const int row = row0 + ai * HALF + m * 16; const float rs = rsqrtf(rsq[row] * (1.0f / KVLR) + NORM_EPS);
#pragma unroll
        for (int bj = 0; bj < 2; ++bj) { const int c0 = u.pn * BM + bj * HALF + wc * 32 + 8 * fq;
          *(u32x4*)(KV + (size_t)row * NKV + c0) = pack8(acc[ai][bj][m][0] * rs, acc[ai][bj][m][1] * rs); } }
  }
};
template <bool ADD, int GOFF> struct EpiMerge { static constexpr bool PERM = true; bf16_t* YM; const bf16_t* G;
  __device__ __forceinline__ void operator()(const Acc& acc, const Unit& u, int wr, int wc, int fr, int fq) const {
    const int row0 = u.pm * BM + wr * 64 + fr;
#pragma unroll
    for (int ai = 0; ai < 2; ++ai)
#pragma unroll
      for (int m = 0; m < 4; ++m) { const int row = row0 + ai * HALF + m * 16;
#pragma unroll
        for (int bj = 0; bj < 2; ++bj) { const int c0 = u.pn * BM + bj * HALF + wc * 32 + 8 * fq;
          const u32x4 gw = *(const u32x4*)(G + (size_t)row * 2048 + GOFF + c0);
          f32x4 a = acc[ai][bj][m][0], b = acc[ai][bj][m][1];
#ifndef DBG_NOGATE
          a[0] *= bf_lo(gw.x); a[1] *= bf_hi(gw.x); a[2] *= bf_lo(gw.y); a[3] *= bf_hi(gw.y); b[0] *= bf_lo(gw.z); b[1] *= bf_hi(gw.z); b[2] *= bf_lo(gw.w); b[3] *= bf_hi(gw.w);
#else
          a[0] += 1e-30f * bf_lo(gw.x);
#endif
          bf16_t* p = YM + (size_t)row * DM + c0;
          if (ADD) { const u32x4 t = *(const u32x4*)p;
            a[0] += bf_lo(t.x); a[1] += bf_hi(t.x); a[2] += bf_lo(t.y); a[3] += bf_hi(t.y); b[0] += bf_lo(t.z); b[1] += bf_hi(t.z); b[2] += bf_lo(t.w); b[3] += bf_hi(t.w); }
          *(u32x4*)p = pack8(a, b); } }
  }
};
}

namespace attn {
constexpr int SHM_V = 64 * 64 * 2, SHM_K = 64 * 256, NBUF = 3, LDS_BYTES = NBUF * SHM_V + NBUF * SHM_K + 8 * 64 * 4;
constexpr float THRL = 11.5f;
#define KSWZ(row, colB) ((row) * 256 + ((colB) ^ (((row) & 15) << 4)))
__device__ __forceinline__ int crow(int r, int hi) { return (r & 3) + 8 * (r >> 2) + 4 * hi; }
typedef short v4i16_t __attribute__((ext_vector_type(4)));
__device__ __forceinline__ s16x4 vtr(const LAS unsigned char* p) { return __builtin_bit_cast(s16x4, __builtin_amdgcn_ds_read_tr16_b64_v4i16((LAS v4i16_t*)p)); }
__device__ __forceinline__ int swap23(int k) { return (k & ~0xC) | ((k & 4) << 1) | ((k & 8) >> 1); }
__device__ __forceinline__ int v_rd_base(int lane) { return ((lane & 3) << 3) | (((lane >> 2) & 3) << 6) | (((lane >> 4) & 1) << 5) | (((lane >> 5) & 1) << 8); }
template <int NB> __device__ __forceinline__ int t_st(int k, int n) { const int kk = swap23(k); return ((kk >> 3) * NB + (n >> 5)) * 512 + ((kk & 7) * 32 + (n & 31)) * 2; }
template <int NB> __device__ __forceinline__ bf16x8 t_frag(const LAS unsigned char* base, int ks, int nb) {
  const s16x4 l = vtr(base + nb * 512 + ks * (1024 * NB)), h = vtr(base + nb * 512 + ks * (1024 * NB) + 512 * NB);
  return (bf16x8){l[0], l[1], l[2], l[3], h[0], h[1], h[2], h[3]};
}
template <int NB> __device__ __forceinline__ int t_stn(int k, int n) { return ((k >> 3) * NB + (n >> 5)) * 512 + ((k & 7) * 32 + (n & 31)) * 2; }
template <bool FIRST> __device__ __forceinline__ float partialSM(f32x16& p0, f32x16& p1, float& mhat, f32x16& negm) {
  float a = fmaxf(fmaxf(p0[0], p0[1]), p0[2]), b = fmaxf(fmaxf(p1[0], p1[1]), p1[2]);
#pragma unroll
  for (int r = 3; r < 15; r += 2) { a = fmaxf(fmaxf(a, p0[r]), p0[r + 1]); b = fmaxf(fmaxf(b, p1[r]), p1[r + 1]); }
  float pmax = fmaxf(fmaxf(a, b), fmaxf(p0[15], p1[15]));
  { auto rr = __builtin_amdgcn_permlane32_swap(__float_as_uint(pmax), __float_as_uint(pmax), false, false);
    pmax = fmaxf(__uint_as_float(rr[0]), __uint_as_float(rr[1])); }
  float alpha = 1.f;
  if (FIRST || !__builtin_expect(__all(pmax <= THRL), 1)) {
    const float dl = FIRST ? pmax : fmaxf(pmax, 0.f);
    mhat += dl;
#pragma unroll
    for (int r = 0; r < 16; ++r) { p0[r] -= dl; p1[r] -= dl; negm[r] = -mhat; }
    if (!FIRST) alpha = __builtin_amdgcn_exp2f(-dl);
  }
#pragma unroll
  for (int r = 0; r < 16; ++r) p0[r] = __builtin_amdgcn_exp2f(p0[r]);
  return alpha;
}
__device__ __forceinline__ void finishSM(f32x16& p0, f32x16& p1, bf16x8& pa0, bf16x8& pa1, bf16x8& pa2, bf16x8& pa3) {
#pragma unroll
  for (int r = 0; r < 16; ++r) p1[r] = __builtin_amdgcn_exp2f(p1[r]);
#define PK8(P, BASE, OUT) do { u32x4 w = {cvt_pk_bf16(P[BASE + 0], P[BASE + 1]), cvt_pk_bf16(P[BASE + 2], P[BASE + 3]), cvt_pk_bf16(P[BASE + 4], P[BASE + 5]), cvt_pk_bf16(P[BASE + 6], P[BASE + 7])}; \
    OUT = __builtin_bit_cast(bf16x8, w); } while (0)
  PK8(p0, 0, pa0); PK8(p0, 8, pa1); PK8(p1, 0, pa2); PK8(p1, 8, pa3);
#undef PK8
}
__device__ __forceinline__ void qkt(f32x16& p0, f32x16& p1, const LAS unsigned char* Ks, const bf16x8* qr, const f32x16& negm, int r32, int hi) {
#pragma unroll
  for (int d0 = 0; d0 < 6; ++d0) { const int cb = (d0 * 16 + hi * 8) * 2;
    const bf16x8 b0 = *(const LAS bf16x8*)(Ks + KSWZ(r32, cb));
    const bf16x8 b1 = *(const LAS bf16x8*)(Ks + KSWZ(32 + r32, cb));
    if (d0 == 0) { p0 = __builtin_amdgcn_mfma_f32_32x32x16_bf16(b0, qr[0], negm, 0, 0, 0); p1 = __builtin_amdgcn_mfma_f32_32x32x16_bf16(b1, qr[0], negm, 0, 0, 0); }
    else { p0 = __builtin_amdgcn_mfma_f32_32x32x16_bf16(b0, qr[d0], p0, 0, 0, 0); p1 = __builtin_amdgcn_mfma_f32_32x32x16_bf16(b1, qr[d0], p1, 0, 0, 0); } }
}
__device__ __forceinline__ void pv2(f32x16* o, f32x16& ol, const LAS unsigned char* vb, bf16x8 pa0, bf16x8 pa1, bf16x8 pa2, bf16x8 pa3) {
  const bf16x8 ones = {0x3F80, 0x3F80, 0x3F80, 0x3F80, 0x3F80, 0x3F80, 0x3F80, 0x3F80};
#pragma unroll
  for (int d0 = 0; d0 < 2; ++d0) {
    const bf16x8 v0 = t_frag<2>(vb, 0, d0), v1 = t_frag<2>(vb, 1, d0), v2 = t_frag<2>(vb, 2, d0), v3 = t_frag<2>(vb, 3, d0);
    o[d0] = __builtin_amdgcn_mfma_f32_32x32x16_bf16(pa0, v0, o[d0], 0, 0, 0);
    o[d0] = __builtin_amdgcn_mfma_f32_32x32x16_bf16(pa1, v1, o[d0], 0, 0, 0);
    o[d0] = __builtin_amdgcn_mfma_f32_32x32x16_bf16(pa2, v2, o[d0], 0, 0, 0);
    o[d0] = __builtin_amdgcn_mfma_f32_32x32x16_bf16(pa3, v3, o[d0], 0, 0, 0);
  }
  ol = __builtin_amdgcn_mfma_f32_32x32x16_bf16(pa0, ones, ol, 0, 0, 0);
  ol = __builtin_amdgcn_mfma_f32_32x32x16_bf16(pa1, ones, ol, 0, 0, 0);
  ol = __builtin_amdgcn_mfma_f32_32x32x16_bf16(pa2, ones, ol, 0, 0, 0);
  ol = __builtin_amdgcn_mfma_f32_32x32x16_bf16(pa3, ones, ol, 0, 0, 0);
}
__device__ __forceinline__ unsigned f2bf(float f) { unsigned u = __float_as_uint(f); return (u + 0x7fffu + ((u >> 16) & 1u)) >> 16; }

__device__ __forceinline__ void attn_unit(int b, int h, int qb, const bf16_t* Q, const bf16_t* KV, const bf16_t* KR, bf16_t* O, LAS unsigned char* lds, const int wid) {
  const int lane = fresh_lane(), tid = wid * 64 + lane, r32 = lane & 31, hi = lane >> 5;
  LAS unsigned char* V_lds = lds; LAS unsigned char* K_lds = lds + NBUF * SHM_V;
  LAS float* ws = (LAS float*)(lds + NBUF * SHM_V + NBUF * SHM_K) + wid * 64; LAS float* al_l = ws + 32;
  float mhat = 0.f; f32x16 o[2] = {}; f32x16 ol = {}; f32x16 negm = {}; bf16x8 qr[6];
  const size_t tok0 = (size_t)b * SEQ;
  const bf16_t* Qw = Q + (tok0 + qb * 256 + wid * 32 + r32) * NQ + h * 96 + hi * 8;
#pragma unroll
  for (int d0 = 0; d0 < 6; ++d0) qr[d0] = *(const bf16x8*)(Qw + d0 * 16);
  const int srow = tid >> 3, sch = tid & 7;
  const char* kvb = (const char*)(KV + tok0 * NKV + h * 128); const char* krb = (const char*)(KR + tok0 * 32);
  const unsigned koff = (unsigned)(srow * NKV + sch * 8) * 2u, roff = (unsigned)(srow * 32 + sch * 4) * 2u;
  const int kst = KSWZ(srow, sch * 16), vst = t_stn<2>(srow, sch * 8), rst = KSWZ(srow, 128 + (sch >> 1) * 16) + (sch & 1) * 8;
  const LAS unsigned char* vb0 = V_lds + v_rd_base(lane);
  bf16x8 ksA, vsA; u32x2 rsA;
#define SLOAD(S, k0) do { const char* kt_ = kvb + (size_t)(k0) * (NKV * 2); ks##S = *(const bf16x8*)(kt_ + koff); vs##S = *(const bf16x8*)(kt_ + koff + 128); rs##S = *(const u32x2*)(krb + (size_t)(k0) * 64 + roff); } while (0)
#define SWRITE(bf, S) do { *(LAS bf16x8*)(K_lds + (bf) * SHM_K + kst) = ks##S; *(LAS bf16x8*)(V_lds + (bf) * SHM_V + vst) = vs##S; *(LAS u32x2*)(K_lds + (bf) * SHM_K + rst) = rs##S; } while (0)
#define RESC(a) do { if (__any((a) != 1.f)) { if (hi == 0) al_l[r32] = (a); LDS_WAIT(); \
    _Pragma("unroll") for (int r = 0; r < 16; ++r) { const float f_ = al_l[crow(r, hi)]; o[0][r] *= f_; o[1][r] *= f_; ol[r] *= f_; } } } while (0)
#define SBAR() __builtin_amdgcn_sched_barrier(0)
  f32x16 pA0, pA1, pB0, pB1; float alpha; constexpr int NT = SEQ / 64;
  const int ka0 = KSWZ(r32, hi * 16);
  const bf16x8 ones = {0x3F80, 0x3F80, 0x3F80, 0x3F80, 0x3F80, 0x3F80, 0x3F80, 0x3F80};
  bf16x8 kfA0, kfA1, kfB0, kfB1, kfC0, kfC1, vf0, vf1, vf2, vf3, wf0, wf1, wf2, wf3; u32x4 pw0, pw1, pw2, pw3;
#define KRD(S, d0, KB) do { const int a_ = ka0 ^ ((d0) << 5); kf##S##0 = *(const LAS bf16x8*)((KB) + a_); kf##S##1 = *(const LAS bf16x8*)((KB) + a_ + 8192); } while (0)
#define MF(A, B, C) __builtin_amdgcn_mfma_f32_32x32x16_bf16(A, B, C, 0, 0, 0)
#define PKW(P, B) (u32x4){cvt_pk_bf16(P[B], P[B + 1]), cvt_pk_bf16(P[B + 2], P[B + 3]), cvt_pk_bf16(P[B + 4], P[B + 5]), cvt_pk_bf16(P[B + 6], P[B + 7])}
#define PAF(k) __builtin_bit_cast(bf16x8, pw##k)
#define PIN(x) asm volatile("" : "+v"(x))
#define EX4(X, B) do { X[B] = __builtin_amdgcn_exp2f(X[B]); X[B + 1] = __builtin_amdgcn_exp2f(X[B + 1]); X[B + 2] = __builtin_amdgcn_exp2f(X[B + 2]); X[B + 3] = __builtin_amdgcn_exp2f(X[B + 3]); PIN(X); } while (0)
#define MX3(a, b, c) fmaxf(fmaxf(a, b), c)
#define PHASE_A(C0, C1, P0, P1, KB, VB, PREV) do { \
    KRD(A, 0, KB); KRD(B, 1, KB); SBAR(); \
    C0 = MF(kfA0, qr[0], negm); if (PREV) vf0 = t_frag<2>(VB, 0, 0); SBAR(); \
    C1 = MF(kfA1, qr[0], negm); KRD(C, 2, KB); SBAR(); \
    C0 = MF(kfB0, qr[1], C0); if (PREV) vf1 = t_frag<2>(VB, 1, 0); SBAR(); \
    C1 = MF(kfB1, qr[1], C1); KRD(A, 3, KB); SBAR(); \
    C0 = MF(kfC0, qr[2], C0); if (PREV) { vf2 = t_frag<2>(VB, 2, 0); pw0 = PKW(P0, 0); PIN(pw0); } SBAR(); \
    C1 = MF(kfC1, qr[2], C1); KRD(B, 4, KB); SBAR(); \
    C0 = MF(kfA0, qr[3], C0); if (PREV) { vf3 = t_frag<2>(VB, 3, 0); pw1 = PKW(P0, 8); PIN(pw1); } SBAR(); \
    C1 = MF(kfA1, qr[3], C1); KRD(C, 5, KB); SBAR(); \
    C0 = MF(kfB0, qr[4], C0); if (PREV) { pw2 = PKW(P1, 0); PIN(pw2); } SBAR(); \
    C1 = MF(kfB1, qr[4], C1); SBAR(); \
    C0 = MF(kfC0, qr[5], C0); if (PREV) { pw3 = PKW(P1, 8); PIN(pw3); } SBAR(); \
    C1 = MF(kfC1, qr[5], C1); SBAR(); } while (0)
#define ONES_DECIDE(C0, C1, PREV, FIRST) do { float m0_, m1_, m2_, m3_; \
    if (PREV) ol = MF(PAF(0), ones, ol); m0_ = MX3(MX3(C0[0], C0[1], C0[2]), MX3(C0[3], C0[4], C0[5]), fmaxf(C0[6], C0[7])); PIN(m0_); SBAR(); \
    if (PREV) ol = MF(PAF(1), ones, ol); m1_ = MX3(MX3(C0[8], C0[9], C0[10]), MX3(C0[11], C0[12], C0[13]), fmaxf(C0[14], C0[15])); PIN(m1_); SBAR(); \
    if (PREV) ol = MF(PAF(2), ones, ol); m2_ = MX3(MX3(C1[0], C1[1], C1[2]), MX3(C1[3], C1[4], C1[5]), fmaxf(C1[6], C1[7])); PIN(m2_); SBAR(); \
    if (PREV) ol = MF(PAF(3), ones, ol); m3_ = MX3(MX3(C1[8], C1[9], C1[10]), MX3(C1[11], C1[12], C1[13]), fmaxf(C1[14], C1[15])); PIN(m3_); SBAR(); \
    float pmax = fmaxf(fmaxf(m0_, m1_), fmaxf(m2_, m3_)); \
    { auto rr = __builtin_amdgcn_permlane32_swap(__float_as_uint(pmax), __float_as_uint(pmax), false, false); pmax = fmaxf(__uint_as_float(rr[0]), __uint_as_float(rr[1])); } \
    alpha = 1.f; \
    if ((FIRST) || !__builtin_expect(__all(pmax <= THRL), 1)) { const float dl = (FIRST) ? pmax : fmaxf(pmax, 0.f); mhat += dl; \
      _Pragma("unroll") for (int r = 0; r < 16; ++r) { C0[r] -= dl; C1[r] -= dl; negm[r] = -mhat; } \
      if (!(FIRST)) alpha = __builtin_amdgcn_exp2f(-dl); } SBAR(); } while (0)
#define PHASE_B(C0, C1, VB) do { \
    o[0] = MF(PAF(0), vf0, o[0]); EX4(C0, 0); wf0 = t_frag<2>(VB, 0, 1); SBAR(); \
    o[0] = MF(PAF(1), vf1, o[0]); EX4(C0, 4); wf1 = t_frag<2>(VB, 1, 1); SBAR(); \
    o[0] = MF(PAF(2), vf2, o[0]); EX4(C0, 8); wf2 = t_frag<2>(VB, 2, 1); SBAR(); \
    o[0] = MF(PAF(3), vf3, o[0]); EX4(C0, 12); wf3 = t_frag<2>(VB, 3, 1); SBAR(); \
    o[1] = MF(PAF(0), wf0, o[1]); EX4(C1, 0); SBAR(); \
    o[1] = MF(PAF(1), wf1, o[1]); EX4(C1, 4); SBAR(); \
    o[1] = MF(PAF(2), wf2, o[1]); EX4(C1, 8); SBAR(); \
    o[1] = MF(PAF(3), wf3, o[1]); EX4(C1, 12); SBAR(); } while (0)
#define EXALL(C0, C1) do { _Pragma("unroll") for (int r = 0; r < 16; ++r) { C0[r] = __builtin_amdgcn_exp2f(C0[r]); C1[r] = __builtin_amdgcn_exp2f(C1[r]); } } while (0)
#define KBUF(i) (K_lds + (i) * SHM_K)
#define VBUF(i) (vb0 + (i) * SHM_V)
#define STEP(C0, C1, P0, P1, T, KS, VS, WS) do { \
    SBAR(); if ((T) + 1 < NT) SLOAD(A, ((T) + 1) * 64); SBAR(); \
    PHASE_A(C0, C1, P0, P1, KBUF(KS), VBUF(VS), true); \
    ONES_DECIDE(C0, C1, true, false); PHASE_B(C0, C1, VBUF(VS)); \
    if ((T) + 1 < NT) SWRITE(WS, A); \
    RESC(alpha); __syncthreads(); } while (0)
  SLOAD(A, 0); VM_WAIT(); SWRITE(0, A); __syncthreads();
  SLOAD(A, 64);
  PHASE_A(pA0, pA1, pA0, pA1, KBUF(0), VBUF(0), false); ONES_DECIDE(pA0, pA1, false, true); EXALL(pA0, pA1);
  SWRITE(1, A); __syncthreads();
  for (int j = 1; j + 5 < NT; j += 6) {
    STEP(pB0, pB1, pA0, pA1, j,     1, 0, 2);
    STEP(pA0, pA1, pB0, pB1, j + 1, 2, 1, 0);
    STEP(pB0, pB1, pA0, pA1, j + 2, 0, 2, 1);
    STEP(pA0, pA1, pB0, pB1, j + 3, 1, 0, 2);
    STEP(pB0, pB1, pA0, pA1, j + 4, 2, 1, 0);
    STEP(pA0, pA1, pB0, pB1, j + 5, 0, 2, 1);
  }
  STEP(pB0, pB1, pA0, pA1, NT - 1, 1, 0, 2);
  pw0 = PKW(pB0, 0); pw1 = PKW(pB0, 8); pw2 = PKW(pB1, 0); pw3 = PKW(pB1, 8);
  pv2(o, ol, VBUF(1), PAF(0), PAF(1), PAF(2), PAF(3));
#undef KRD
#undef MF
#undef PKW
#undef PAF
#undef PIN
#undef EX4
#undef MX3
#undef PHASE_A
#undef ONES_DECIDE
#undef PHASE_B
#undef EXALL
#undef KBUF
#undef VBUF
#undef STEP
  float rli[16];
#pragma unroll
  for (int r = 0; r < 16; ++r) rli[r] = __builtin_amdgcn_rcpf(ol[r]);
  bf16_t* Ow = O + (tok0 + qb * 256 + wid * 32) * 512 + h * 64;
#pragma unroll
  for (int r = 0; r < 16; ++r) { const int orow = crow(r, hi);
#pragma unroll
    for (int d0 = 0; d0 < 2; ++d0) Ow[(size_t)orow * 512 + d0 * 32 + r32] = (bf16_t)f2bf(o[d0][r] * rli[r]); }
  VM_WAIT(); __syncthreads();
#undef SLOAD
#undef SWRITE
#undef RESC
#undef SBAR
}
}

namespace fft {
using attn::crow; using attn::t_st; using attn::t_frag; using attn::v_rd_base; using attn::f2bf;
__device__ __forceinline__ int am64(int row, int k) { return row * 128 + ((((k >> 3) ^ (row & 7))) << 4) + (k & 7) * 2; }
__device__ __forceinline__ int am128(int row, int k) { return row * 256 + ((((k >> 3) ^ (row & 15))) << 4) + (k & 7) * 2; }
constexpr int T_OFF = 0, A_OFF = 65536, TWL_OFF = 65536 + 24576;
__device__ __forceinline__ void stage1(const bf16_t* V, bf16_t* Y, const bf16_t* c64  , const float* tw, LAS unsigned char* lds, int first, int stride, const int wid) {
  const int lane = fresh_lane(), tid = wid * 64 + lane, r32 = lane & 31, hi = lane >> 5;
  LAS unsigned char* T = lds + T_OFF; LAS unsigned char* A = lds + A_OFF; LAS f32x2* twl = (LAS f32x2*)(lds + TWL_OFF);
#pragma unroll
  for (int i = 0; i < 3; ++i) { const int idx = tid + 512 * i, mi = idx >> 9, ch = idx & 511, row = ch >> 3, kc = ch & 7;
    *(LAS u32x4*)(A + mi * 8192 + am64(row, kc * 8)) = *(const u32x4*)(c64 + mi * 4096 + row * 64 + kc * 8); }
  u32x4 st[8];
#define F1_LOAD(u) do { const int b_ = (u) >> 8, b2_ = ((u) >> 1) & 127, hf_ = (u) & 1; \
    _Pragma("unroll") for (int i = 0; i < 8; ++i) { const int idx = tid + 512 * i, a = idx >> 6, n = (idx & 63) * 8; const int gcol = (n < 256) ? hf_ * 256 + n : 512 + hf_ * 256 + (n - 256); \
      st[i] = *(const u32x4*)(V + ((size_t)b_ * SEQ + 128 * a + b2_) * 1024 + gcol); } } while (0)
  int u = first; if (u >= 1024) return;
  F1_LOAD(u);
  for (;;) {
    const int b = u >> 8, b2 = (u >> 1) & 127, hf = u & 1;
#pragma unroll
    for (int i = 0; i < 8; ++i) { const int idx = tid + 512 * i, a = idx >> 6, n = (idx & 63) * 8; *(LAS u32x4*)(T + t_st<16>(a, n)) = st[i]; }
    if (tid < 64) twl[tid] = *(const f32x2*)(tw + ((size_t)tid * 128 + b2) * 2);
    __syncthreads();
    const int un = u + stride; if (un < 1024) F1_LOAD(un);
    const LAS unsigned char* tb = T + v_rd_base(lane);
    {
      asm volatile("" ::: "memory");
      const int nbr = wid, nbi = 8 + wid;
      f32x16 ar[2] = {}, ai[2] = {};
#pragma unroll
      for (int ks = 0; ks < 4; ++ks) {
        const bf16x8 Br = t_frag<16>(tb, ks, nbr), Bi = t_frag<16>(tb, ks, nbi);
#pragma unroll
        for (int mb = 0; mb < 2; ++mb) { const int off = am64(32 * mb + r32, 16 * ks + 8 * hi);
          const bf16x8 Ac = *(const LAS bf16x8*)(A + off), As = *(const LAS bf16x8*)(A + 8192 + off), An = *(const LAS bf16x8*)(A + 16384 + off);
          ar[mb] = __builtin_amdgcn_mfma_f32_32x32x16_bf16(Ac, Br, ar[mb], 0, 0, 0); ar[mb] = __builtin_amdgcn_mfma_f32_32x32x16_bf16(As, Bi, ar[mb], 0, 0, 0);
          ai[mb] = __builtin_amdgcn_mfma_f32_32x32x16_bf16(Ac, Bi, ai[mb], 0, 0, 0); ai[mb] = __builtin_amdgcn_mfma_f32_32x32x16_bf16(An, Br, ai[mb], 0, 0, 0); }
      }
      const int colr = hf * 256 + 32 * wid + r32;
#pragma unroll
      for (int mb = 0; mb < 2; ++mb)
#pragma unroll
        for (int r = 0; r < 16; ++r) { const int c = 32 * mb + crow(r, hi); const f32x2 t = twl[c]; const float yr = ar[mb][r], yi = ai[mb][r];
          bf16_t* dst = Y + (((size_t)b * 64 + c) * 128 + b2) * 1024 + colr;
          dst[0] = (bf16_t)f2bf(yr * t.x + yi * t.y); dst[512] = (bf16_t)f2bf(yi * t.x - yr * t.y); }
    }
    __syncthreads();
    if (un >= 1024) break; u = un;
  }
#undef F1_LOAD
}
__device__ __forceinline__ void stage2(const bf16_t* Y, bf16_t* F, const bf16_t* c128  , LAS unsigned char* lds, int first, int stride, const int wid) {
  const int lane = fresh_lane(), tid = wid * 64 + lane, r32 = lane & 31, hi = lane >> 5;
  LAS unsigned char* T = lds + T_OFF; LAS unsigned char* A = lds + A_OFF;
#pragma unroll
  for (int i = 0; i < 8; ++i) { const int idx = tid + 512 * i, mi = idx >> 11, ch = idx & 2047, row = ch >> 4, kc = ch & 15;
    *(LAS u32x4*)(A + mi * 32768 + am128(row, kc * 8)) = *(const u32x4*)(c128 + mi * 16384 + row * 128 + kc * 8); }
  u32x4 st[8];
#define F2_LOAD(u) do { const int b_ = (u) >> 8, c_ = ((u) >> 2) & 63, qt_ = (u) & 3; \
    _Pragma("unroll") for (int i = 0; i < 8; ++i) { const int idx = tid + 512 * i, row = idx >> 5, n = (idx & 31) * 8; const int gcol = (n < 128) ? qt_ * 128 + n : 512 + qt_ * 128 + (n - 128); \
      st[i] = *(const u32x4*)(Y + (((size_t)b_ * 64 + c_) * 128 + row) * 1024 + gcol); } } while (0)
  int u = first; if (u >= 1024) return;
  F2_LOAD(u);
  for (;;) {
    const int b = u >> 8, c = (u >> 2) & 63, qt = u & 3;
#pragma unroll
    for (int i = 0; i < 8; ++i) { const int idx = tid + 512 * i, row = idx >> 5, n = (idx & 31) * 8; *(LAS u32x4*)(T + t_st<8>(row, n)) = st[i]; }
    __syncthreads();
    const int un = u + stride; if (un < 1024) F2_LOAD(un);
    const LAS unsigned char* tb = T + v_rd_base(lane);
    const int nb = wid & 3, mh = wid >> 2;
    asm volatile("" ::: "memory");
    f32x16 acc[2] = {};
#pragma unroll
    for (int ks = 0; ks < 8; ++ks) {
      const bf16x8 Br = t_frag<8>(tb, ks, nb), Bi = t_frag<8>(tb, ks, 4 + nb);
#pragma unroll
      for (int mb = 0; mb < 2; ++mb) { const int off = am128(64 * mh + 32 * mb + r32, 16 * ks + 8 * hi);
        const bf16x8 Ac = *(const LAS bf16x8*)(A + off), As = *(const LAS bf16x8*)(A + 32768 + off);
        acc[mb] = __builtin_amdgcn_mfma_f32_32x32x16_bf16(Ac, Br, acc[mb], 0, 0, 0); acc[mb] = __builtin_amdgcn_mfma_f32_32x32x16_bf16(As, Bi, acc[mb], 0, 0, 0); }
    }
#pragma unroll
    for (int mb = 0; mb < 2; ++mb)
#pragma unroll
      for (int r = 0; r < 16; ++r) { const int d = 64 * mh + 32 * mb + crow(r, hi);
        F[((size_t)b * SEQ + c + 64 * d) * 512 + qt * 128 + 32 * nb + r32] = (bf16_t)f2bf(acc[mb][r]); }
    __syncthreads();
    if (un >= 1024) break; u = un;
  }
#undef F2_LOAD
}
}

#define XB_TMO      128
#define XB_XCNT(j)  (256  + 64 * (j))
#define XB_XSUB(j)  (1280 + 64 * (j))
#define XB_XGEN(j)  (2304 + 64 * (j))
#define XB_TOP      3328
#define XB_TOPGEN   3392
#define XCD_BAR_WORDS 3456
#define XB_SPIN_CAP (1u << 18)
__device__ __forceinline__ unsigned xb_ld(unsigned* p)              { return __hip_atomic_load(p, __ATOMIC_RELAXED, __HIP_MEMORY_SCOPE_AGENT); }
__device__ __forceinline__ unsigned xb_add(unsigned* p, unsigned v) { return __hip_atomic_fetch_add(p, v, __ATOMIC_RELAXED, __HIP_MEMORY_SCOPE_AGENT); }
__device__ __forceinline__ unsigned xb_xcc_id() { return (unsigned)__builtin_amdgcn_s_getreg((3 << 11) | 20) & 0xFu; }
#define XB_SPIN(cond, bar) do { unsigned _sp = 0; while (cond) { __builtin_amdgcn_s_sleep(1); \
    if ((++_sp & 255u) == 0u) { if (xb_ld(&(bar)[XB_TMO])) break; if (_sp > XB_SPIN_CAP) { atomicAdd(&(bar)[XB_TMO], 1u); break; } } } } while (0)
struct XcdBarrier { unsigned* bar; unsigned x; volatile LAS unsigned* st; };
__device__ __forceinline__ XcdBarrier xcd_barrier_post(unsigned* bar, volatile LAS unsigned* st) {
  XcdBarrier b; b.bar = bar; b.x = xb_xcc_id(); b.st = st;
  if (threadIdx.x == 0) (void)xb_add(&bar[XB_XCNT(b.x)], 1u);
  return b;
}
__device__ __forceinline__ void xcd_barrier_complete(unsigned* bar, unsigned x, unsigned& nloc, unsigned& nx) {
  const unsigned G = gridDim.x * gridDim.y * gridDim.z;
  unsigned sum, cnt, mine, sp = 0u;
  for (;;) {
    sum = 0u; cnt = 0u; mine = 0u;
#pragma unroll
    for (unsigned j = 0; j < 16; ++j) { const unsigned c = xb_ld(&bar[XB_XCNT(j)]); sum += c; cnt += (c > 0u) ? 1u : 0u; mine = (j == x) ? c : mine; }
    if (sum == G) break;
    __builtin_amdgcn_s_sleep(1);
    if ((++sp & 255u) == 0u) { if (xb_ld(&bar[XB_TMO])) break; if (sp > XB_SPIN_CAP) { atomicAdd(&bar[XB_TMO], 1u); break; } }
  }
  nloc = mine > 0u ? mine : 1u; nx = cnt > 0u ? cnt : 1u;
}
__device__ __forceinline__ void xcd_barrier(const XcdBarrier& b) {
  asm volatile("s_waitcnt vmcnt(0)" ::: "memory");
  __syncthreads();
  if (threadIdx.x == 0) {
    unsigned* bar = b.bar;
    __builtin_amdgcn_s_waitcnt(0);
    unsigned nloc = b.st[0], nx = b.st[1];
    if (nloc == 0u) { xcd_barrier_complete(bar, b.x, nloc, nx); b.st[0] = nloc; b.st[1] = nx; }
    const unsigned old = xb_add(&bar[XB_XSUB(b.x)], 1u);
    const unsigned gen = old / nloc;
    if (old + 1u == (gen + 1u) * nloc) {
      __builtin_amdgcn_fence(__ATOMIC_RELEASE, "agent");
      asm volatile("s_waitcnt vmcnt(0)" ::: "memory");
      const unsigned og = xb_add(&bar[XB_TOP], 1u);
      const unsigned tg = og / nx;
      if (og + 1u == (tg + 1u) * nx) xb_add(&bar[XB_TOPGEN], 1u);
      else XB_SPIN(xb_ld(&bar[XB_TOPGEN]) == tg, bar);
      __builtin_amdgcn_fence(__ATOMIC_ACQUIRE, "agent");
      xb_add(&bar[XB_XGEN(b.x)], 1u);
      asm volatile("s_waitcnt vmcnt(0)" ::: "memory");
    } else {
      XB_SPIN(xb_ld(&bar[XB_XGEN(b.x)]) == gen, bar);
      __builtin_amdgcn_fence(__ATOMIC_ACQUIRE, "agent");
      asm volatile("s_waitcnt vmcnt(0)" ::: "memory");
    }
  }
  __syncthreads();
}

constexpr int NWAVES = 8;
constexpr int RING_BYTES = 131072, LDSCTL_OFF = RING_BYTES, MISC_OFF = LDSCTL_OFF + 320, FOLD_OFF = RING_BYTES + 1024;
constexpr int LDS_BYTES = 147456;
struct Args { const float* in[23]; float* out; unsigned char* ws; int ph_lo, ph_hi; };
struct Frame {
  LAS unsigned char* lds; int wave, vcu, G;
  const float* const* in; float* out; unsigned char* ws;
};

__device__ __forceinline__ void p0_transpose_item(const float* W, int ldw, int k0, int n0, bf16_t* WT, int ldwt, int drow0, bool perm, const float* kscale, float cscale, LAS float* scr, int lane) {
#pragma unroll 8
  for (int i = 0; i < 32; ++i) { const int kk = 2 * i + (lane >> 5); float v = W[(size_t)(k0 + kk) * ldw + n0 + (lane & 31)]; if (kscale) v *= kscale[k0 + kk]; scr[kk * 33 + (lane & 31)] = v * cscale; }
  LDS_WAIT(); asm volatile("" ::: "memory");
  const int c = lane & 7;
#pragma unroll
  for (int j = 0; j < 4; ++j) { const int n = (lane >> 3) + 8 * j; const LAS float* s = scr + (8 * c) * 33 + n;
    u32x4 o; o.x = cvt_pk_bf16(s[0 * 33], s[1 * 33]); o.y = cvt_pk_bf16(s[2 * 33], s[3 * 33]); o.z = cvt_pk_bf16(s[4 * 33], s[5 * 33]); o.w = cvt_pk_bf16(s[6 * 33], s[7 * 33]);
    const int dr = drow0 + (perm ? (n < 16 ? 2 * n : 2 * (n - 16) + 1) : n);
    *(u32x4*)(WT + (size_t)dr * ldwt + k0 + 8 * c) = o; }
  LDS_WAIT(); asm volatile("" ::: "memory");
}
constexpr int I_GU = 16 * 88, I_DN = 44 * 32, I_WIN = 16 * 85, I_WQ = 6 * 24, I_WKV = 4 * 32, I_WF = 8 * 32, I_WO = 16 * 32;
constexpr int NTRANS = 4 * I_GU + 2 * I_DN + I_WIN + I_WQ + I_WKV + 2 * I_WF + I_WO;
constexpr int NMODI = 144 * 32;
__device__ __forceinline__ void p0_trans_dispatch(const Frame& F, int r, LAS float* scr) {
  unsigned char* ws = F.ws; const int lane = fresh_lane();
  if (r < 4 * I_GU) { const int j = r / I_GU, it = r % I_GU, kb = it / 88, nb = it % 88, n0 = nb * 32;
    const float* W = j == 0 ? F.in[6] : j == 1 ? F.in[7] : j == 2 ? F.in[19] : F.in[20]; bf16_t* WT = (bf16_t*)(ws + (j < 2 ? WS_WGU1 : WS_WGU2));
    p0_transpose_item(W, DFF, kb * 64, n0, WT, DM, (n0 >> 7) * 256 + (j & 1) * 128 + (n0 & 127), false, nullptr, 1.f, scr, lane); return; }
  r -= 4 * I_GU;
  if (r < 2 * I_DN) { const int j = r / I_DN, it = r % I_DN, kb = it / 32, nb = it % 32;
    p0_transpose_item(j ? F.in[21] : F.in[8], DM, kb * 64, nb * 32, (bf16_t*)(ws + (j ? WS_WD2 : WS_WD1)), DFF, nb * 32, false, nullptr, 1.f, scr, lane); return; }
  r -= 2 * I_DN;
  if (r < I_WIN) { const int kb = r / 85, nb = r % 85, n0 = 512 + nb * 32; int dr; bool perm = false;
    if (n0 < 896) dr = 3072 + (n0 - 512); else if (n0 < 1152) dr = 3456 + (n0 - 896); else if (n0 < 1184) { dr = 3712; perm = true; } else dr = 1024 + (n0 - 1184);
    p0_transpose_item(F.in[10], 3232, kb * 64, n0, (bf16_t*)(ws + WS_WIN), DM, dr, perm, nullptr, 1.f, scr, lane); return; }
  r -= I_WIN;
  if (r < I_WQ) { const int kb = r / 24, nb = r % 24, n0 = nb * 32;
    p0_transpose_item(F.in[12], NQ, kb * 64, n0, (bf16_t*)(ws + WS_WQ), QLR, n0, (n0 % 96) == 64, F.in[11], SCQ, scr, lane); return; }
  r -= I_WQ;
  if (r < I_WKV) { const int kb = r / 32, nb = r % 32;
    p0_transpose_item(F.in[14], NKV, kb * 64, nb * 32, (bf16_t*)(ws + WS_WKV), KVLR, nb * 32, false, F.in[13], 1.f, scr, lane); return; }
  r -= I_WKV;
  if (r < 2 * I_WF) { const int j = r / I_WF, it = r % I_WF, kb = it / 32, nb = it % 32;
    p0_transpose_item(j ? F.in[16] : F.in[15], DM, kb * 64, nb * 32, (bf16_t*)(ws + (j ? WS_WM : WS_WF)), 512, nb * 32, false, nullptr, 1.f, scr, lane); return; }
  r -= 2 * I_WF;
  { const int kb = r / 32, nb = r % 32;
    p0_transpose_item(F.in[17], DM, kb * 64, nb * 32, (bf16_t*)(ws + WS_WO), DM, nb * 32, false, nullptr, 1.f, scr, lane); }
}
__device__ __forceinline__ void p0_mod_item(const Frame& F, int it) {
  const int nb = it % 144, kc = it / 144, n = nb * 64 + fresh_lane(); const float* cin = F.in[1]; const float* W = F.in[3] + (size_t)(kc * 32) * NADA + n;
  float acc[4] = {0.f, 0.f, 0.f, 0.f};
#pragma unroll 8
  for (int kk = 0; kk < 32; ++kk) { const float w = W[(size_t)kk * NADA];
#pragma unroll
    for (int b = 0; b < 4; ++b) { const float cv = cin[b * DM + kc * 32 + kk]; acc[b] += cv * fast_sigmoid(cv) * w; } }
  float* mod = (float*)(F.ws + OFF_MOD);
#pragma unroll
  for (int b = 0; b < 4; ++b) { float v = acc[b]; if (kc == 0) v += F.in[4][n]; __hip_atomic_fetch_add(mod + b * NADA + n, v, __ATOMIC_RELAXED, __HIP_MEMORY_SCOPE_AGENT); }
}
__device__ __forceinline__ void p0_fold_item(const Frame& F, int it) {
  LAS float* tile = (LAS float*)(F.lds + FOLD_OFF); LAS float* cosT = tile + 2048;
  const int kc = it >> 2, g = it & 3, k0 = kc * 16, tid = F.wave * 64 + fresh_lane();
  { const int idx = tid * 4, kk = idx >> 7, c = idx & 127; *(LAS f32x4*)(tile + idx) = *(const f32x4*)(F.in[10] + (size_t)(k0 + kk) * 3232 + g * 128 + c); }
  if (tid < 128) cosT[tid] = __builtin_amdgcn_cosf((float)tid * (1.0f / 128.0f)) * 0.08838834764831845f;
  __syncthreads();
  const int n = tid & 255, ri = n >> 7, m = n & 127, kh = tid >> 8;
  float acc[8] = {0.f, 0.f, 0.f, 0.f, 0.f, 0.f, 0.f, 0.f};
  for (int c = 0; c < 128; ++c) { const int idx = (m * c) & 127; const float tv = ri ? -cosT[(idx - 32) & 127] : cosT[idx];
#pragma unroll
    for (int q = 0; q < 8; ++q) acc[q] += tile[(kh * 8 + q) * 128 + c] * tv; }
  u32x4 o; o.x = cvt_pk_bf16(acc[0], acc[1]); o.y = cvt_pk_bf16(acc[2], acc[3]); o.z = cvt_pk_bf16(acc[4], acc[5]); o.w = cvt_pk_bf16(acc[6], acc[7]);
  *(u32x4*)((bf16_t*)(F.ws + WS_WIN) + (size_t)(ri * 512 + g * 128 + m) * DM + k0 + kh * 8) = o;
  __syncthreads();
}
__device__ __forceinline__ void p0_prologue(const Frame& F) {
  unsigned char* ws = F.ws;
  for (int it = blockIdx.x; it < 256; it += F.G) p0_fold_item(F, it);
  LAS float* scr = (LAS float*)(F.lds + F.wave * 16384);
  const int gw = F.vcu * NWAVES + F.wave, NGW = F.G * NWAVES;
  for (int it = gw; it < NMODI; it += NGW) p0_mod_item(F, it);
  for (int it = gw; it < NTRANS; it += NGW) p0_trans_dispatch(F, it, scr);
  const int gt = blockIdx.x * 512 + F.wave * 64 + fresh_lane(), NGT = F.G * 512;
  { const int* pos = (const int*)F.in[2]; float* rope = (float*)(ws + WS_ROPE);
    for (int e = gt; e < MTOK * 16; e += NGT) { const int tok = e >> 4, j = e & 15;
      const double c4 = (j & 3) == 0 ? 1.0 : (j & 3) == 1 ? 0.5623413251903491 : (j & 3) == 2 ? 0.31622776601683794 : 0.1778279410038923;
      const double p10 = (j >> 2) == 0 ? 1.0 : (j >> 2) == 1 ? 0.1 : (j >> 2) == 2 ? 0.01 : 0.001;
      const float inv = (float)(c4 * p10); const float ang = (float)pos[tok] * inv;
      double t = (double)ang * 0.15915494309189535; t -= __builtin_floor(t); const float tf = (float)t;
      rope[(size_t)tok * 32 + j] = __builtin_amdgcn_cosf(tf); rope[(size_t)tok * 32 + 16 + j] = __builtin_amdgcn_sinf(tf); } }
  { float* tw = (float*)(ws + WS_TW);
    for (int e = gt; e < 64 * 128; e += NGT) { const int c = e >> 7, b2 = e & 127; const float t = (float)((c * b2) & 8191) * (1.0f / 8192.0f);
      tw[2 * e] = __builtin_amdgcn_cosf(t); tw[2 * e + 1] = __builtin_amdgcn_sinf(t); } }
  { bf16_t* c64 = (bf16_t*)(ws + WS_C64);
    for (int e = gt; e < 4096; e += NGT) { const int c = e >> 6, a = e & 63; const float t = (float)((c * a) & 63) * (1.0f / 64.0f);
      const float cs = __builtin_amdgcn_cosf(t) * 0.125f, sn = __builtin_amdgcn_sinf(t) * 0.125f;
      c64[e] = (bf16_t)attn::f2bf(cs); c64[4096 + e] = (bf16_t)attn::f2bf(sn); c64[8192 + e] = (bf16_t)attn::f2bf(-sn); } }
  { bf16_t* c128 = (bf16_t*)(ws + WS_C128);
    for (int e = gt; e < 16384; e += NGT) { const int d = e >> 7, b2 = e & 127; const float t = (float)((d * b2) & 127) * (1.0f / 128.0f);
      c128[e] = (bf16_t)attn::f2bf(__builtin_amdgcn_cosf(t) * 0.08838834764831845f); c128[16384 + e] = (bf16_t)attn::f2bf(__builtin_amdgcn_sinf(t) * 0.08838834764831845f); } }
  { u32x4* z = (u32x4*)((bf16_t*)(ws + WS_WIN) + (size_t)3744 * DM);
    for (int e = gt; e < 96 * DM / 8; e += NGT) z[e] = (u32x4){0u, 0u, 0u, 0u}; }
}
__device__ __forceinline__ void norm_mod_phase(const Frame& F, const float* x, const float* g, const float* mod_shift, const float* mod_scale, bf16_t* H) {
  const int gw = F.vcu * NWAVES + F.wave, NGW = F.G * NWAVES, lane = fresh_lane();
  for (int ch = gw; ch < MTOK / 16; ch += NGW) {
    const int row0 = ch * 16, b = row0 / SEQ;
    f32x4 av[4], bv[4];
#pragma unroll
    for (int j = 0; j < 4; ++j) { const int col = 4 * lane + 256 * j; const f32x4 gg = *(const f32x4*)(g + col), sc = *(const f32x4*)(mod_scale + (size_t)b * NADA + col);
      av[j] = gg * (1.0f + sc); bv[j] = *(const f32x4*)(mod_shift + (size_t)b * NADA + col); }
    for (int r = 0; r < 16; ++r) {
      const f32x4* xr = (const f32x4*)(x + (size_t)(row0 + r) * DM) + lane; f32x4 v[4]; float s = 0.f;
#pragma unroll
      for (int j = 0; j < 4; ++j) { v[j] = xr[64 * j]; s += (v[j][0] * v[j][0] + v[j][1] * v[j][1]) + (v[j][2] * v[j][2] + v[j][3] * v[j][3]); }
      const float rs = rsqrtf(wave_sum(s) * (1.0f / DM) + NORM_EPS);
      u32x2* o8 = (u32x2*)(H + (size_t)(row0 + r) * DM) + lane;
#pragma unroll
      for (int j = 0; j < 4; ++j) { const f32x4 y = v[j] * rs * av[j] + bv[j]; u32x2 w; w.x = cvt_pk_bf16(y[0], y[1]); w.y = cvt_pk_bf16(y[2], y[3]); o8[64 * j] = w; }
    }
  }
}
__device__ __forceinline__ void final_norm_phase(const Frame& F, float* x, const float* g) {
  const int gw = F.vcu * NWAVES + F.wave, NGW = F.G * NWAVES, lane = fresh_lane();
  f32x4 gv[4];
#pragma unroll
  for (int j = 0; j < 4; ++j) gv[j] = *(const f32x4*)(g + 4 * lane + 256 * j);
  for (int row = gw; row < MTOK; row += NGW) {
    f32x4* xr = (f32x4*)(x + (size_t)row * DM) + lane; f32x4 v[4]; float s = 0.f;
#pragma unroll
    for (int j = 0; j < 4; ++j) { v[j] = xr[64 * j]; s += (v[j][0] * v[j][0] + v[j][1] * v[j][1]) + (v[j][2] * v[j][2] + v[j][3] * v[j][3]); }
    const float rs = rsqrtf(wave_sum(s) * (1.0f / DM) + NORM_EPS);
#pragma unroll
    for (int j = 0; j < 4; ++j) xr[64 * j] = v[j] * rs * gv[j];
  }
}

constexpr int NPHASE = 14;
__global__ void __launch_bounds__(NWAVES * 64, 2) mk_fwd(Args args) {
  extern __shared__ __attribute__((aligned(16))) unsigned char lds_raw[];
  Frame F;
  F.lds = (LAS unsigned char*)lds_raw; F.wave = __builtin_amdgcn_readfirstlane(threadIdx.x >> 6);
  F.G = gridDim.x; { const int bx = blockIdx.x; F.vcu = (F.G % 8 == 0) ? (bx % 8) * (F.G / 8) + bx / 8 : bx; }
  F.in = args.in; F.out = args.out; F.ws = args.ws;
  unsigned char* ws = args.ws;
  for (int u = threadIdx.x; u < (LDS_BYTES - LDSCTL_OFF) / 4; u += NWAVES * 64) ((LAS unsigned*)(F.lds + LDSCTL_OFF))[u] = 0u;
  __syncthreads();
#if MK_SINGLE
  XcdBarrier bar = xcd_barrier_post((unsigned*)(ws + WS_CTL) + CW_BAR, (volatile LAS unsigned*)(F.lds + MISC_OFF) + 8);
#define GRID_BAR() xcd_barrier(bar)
#else
#define GRID_BAR() do {} while (0)
#endif
  const int lo = args.ph_lo, hi = args.ph_hi;
#ifndef PH_MASK
#define PH_MASK 0xFFFF
#endif
#define IN(k) (((PH_MASK >> (k)) & 1) && lo <= (k) && (k) < hi)
#define SEAM(k) do { if (IN(k) && IN((k) + 1)) GRID_BAR(); } while (0)
  const float* mod = (const float*)(ws + OFF_MOD);
  float* rsq_q = (float*)(ws + OFF_RSQQ); float* rsq_kv = (float*)(ws + OFF_RSQKV);
  const float* rope = (const float*)(ws + WS_ROPE);
  bf16_t* H = (bf16_t*)(ws + WS_H); bf16_t* ACT = (bf16_t*)(ws + WS_BIG);
  bf16_t* Vb = (bf16_t*)(ws + WS_V); bf16_t* Yb = (bf16_t*)(ws + WS_Y); bf16_t* Fb = (bf16_t*)(ws + WS_F); bf16_t* ZL = (bf16_t*)(ws + WS_ZL); bf16_t* Ob = (bf16_t*)(ws + WS_O);
  bf16_t* Qb = (bf16_t*)(ws + WS_H); bf16_t* KVb = (bf16_t*)(ws + WS_KV); bf16_t* KRb = (bf16_t*)(ws + WS_KR); bf16_t* GT = (bf16_t*)(ws + WS_GATES); bf16_t* YM = (bf16_t*)(ws + WS_H);
  const int cu = (int)blockIdx.x;

  if (IN(0)) { p0_prologue(F); } SEAM(0);
#ifndef DUP
#define DUP 0
#endif
  if (IN(1)) { for (int rep = 0; rep < 1 + ((DUP >> 0) & 1); ++rep) norm_mod_phase(F, F.in[0], F.in[5], mod + 0 * DM, mod + 1 * DM, H); } SEAM(1);
  if (IN(2)) { for (int rep = 0; rep < 1 + ((DUP >> 1) & 1); ++rep) { pg8::Gemm g{H, (const bf16_t*)(ws + WS_WGU1), MTOK, 2 * DFF, DM, DM, DM}; pg8::StaticOrder S; S.init(MTOK, 2 * DFF, F.G, cu);
    pg8::EpiSwiglu E{ACT}; pg8::gemm_phase(F.lds, g, S, E, F.wave); } } SEAM(2);
  if (IN(3)) { pg8::Gemm g{ACT, (const bf16_t*)(ws + WS_WD1), MTOK, DM, DFF, DFF, DFF}; pg8::StaticOrder S; S.init(MTOK, DM, F.G, cu);
    pg8::EpiResid E{F.in[0], F.out, mod + 2 * DM, 0.5f}; pg8::gemm_phase(F.lds, g, S, E, F.wave); } SEAM(3);
  if (IN(4)) { norm_mod_phase(F, F.out, F.in[9], mod + 3 * DM, mod + 4 * DM, H); } SEAM(4);
  if (IN(5)) { pg8::Gemm g{H, (const bf16_t*)(ws + WS_WIN), MTOK, NWIN, DM, DM, DM}; pg8::StaticOrder S; S.init(MTOK, NWIN, F.G, cu);
    pg8::EpiWin E{Vb, GT, ZL, KRb, rsq_q, rsq_kv, rope}; pg8::gemm_phase(F.lds, g, S, E, F.wave); } SEAM(5);
#ifndef P6_PART
#define P6_PART 7
#endif
  if (IN(6)) {
    if (P6_PART & 1) { pg8::Gemm g{ZL, (const bf16_t*)(ws + WS_WQ), MTOK, NQ, QLR, ZLW, QLR}; pg8::StaticOrder S; S.init(MTOK, NQ, F.G, cu);
      pg8::EpiQ E{Qb, rsq_q, rope}; pg8::gemm_phase(F.lds, g, S, E, F.wave); }
    if (P6_PART & 2) { pg8::Gemm g{ZL + QLR, (const bf16_t*)(ws + WS_WKV), MTOK, NKV, KVLR, ZLW, KVLR}; pg8::StaticOrder S; S.init(MTOK, NKV, F.G, F.G - 1 - cu);
      pg8::EpiKV E{KVb, rsq_kv}; pg8::gemm_phase(F.lds, g, S, E, F.wave); }
    if (P6_PART & 4) for (int rep = 0; rep < 1 + ((DUP >> 2) & 1); ++rep) fft::stage1(Vb, Yb, (const bf16_t*)(ws + WS_C64), (const float*)(ws + WS_TW), F.lds, F.vcu, F.G, F.wave);
  } SEAM(6);
  if (IN(7)) {
    for (int rep = 0; rep < 1 + ((DUP >> 3) & 1); ++rep) fft::stage2(Yb, Fb, (const bf16_t*)(ws + WS_C128), F.lds, F.vcu, F.G, F.wave);
    { const int xl = F.vcu >> 5, qb = F.vcu & 31;
      for (int i = 0; i < 4 * (1 + ((DUP >> 4) & 1)); ++i) { const int bh = xl + 8 * (i & 3); if (F.G == 256) attn::attn_unit(bh >> 3, bh & 7, qb, Qb, KVb, KRb, Ob, F.lds, F.wave); }
      if (F.G != 256) for (int uu = cu; uu < 1024; uu += F.G) attn::attn_unit(uu >> 8, (uu >> 5) & 7, uu & 31, Qb, KVb, KRb, Ob, F.lds, F.wave); }
  } SEAM(7);
#ifndef MERGE_PART
#define MERGE_PART 3
#endif
  if (IN(8)) {
#ifndef DBG_SRC
#define DBG_SRC 0
#endif
    if (MERGE_PART & 1) { pg8::Gemm g{DBG_SRC == 1 ? Vb : DBG_SRC == 2 ? Yb : Fb, (const bf16_t*)(ws + WS_WF), MTOK, DM, 512, DBG_SRC ? 1024 : 512, 512}; pg8::StaticOrder S; S.init(MTOK, DM, F.G, cu);
      pg8::EpiMerge<false, 0> E{YM, GT}; pg8::gemm_phase(F.lds, g, S, E, F.wave); }
    if (MERGE_PART == 3) { pg8::Gemm g{Ob, (const bf16_t*)(ws + WS_WM), MTOK, DM, 512, 512, 512}; pg8::StaticOrder S; S.init(MTOK, DM, F.G, cu);
      pg8::EpiMerge<true, 1024> E{YM, GT}; pg8::gemm_phase(F.lds, g, S, E, F.wave); }
    if (MERGE_PART == 2) { pg8::Gemm g{Ob, (const bf16_t*)(ws + WS_WM), MTOK, DM, 512, 512, 512}; pg8::StaticOrder S; S.init(MTOK, DM, F.G, cu);
      pg8::EpiMerge<false, 1024> E{YM, GT}; pg8::gemm_phase(F.lds, g, S, E, F.wave); }
  } SEAM(8);
  if (IN(9)) { pg8::Gemm g{YM, (const bf16_t*)(ws + WS_WO), MTOK, DM, DM, DM, DM}; pg8::StaticOrder S; S.init(MTOK, DM, F.G, cu);
    pg8::EpiResid E{F.out, F.out, mod + 5 * DM, 1.0f}; pg8::gemm_phase(F.lds, g, S, E, F.wave); } SEAM(9);
  if (IN(10)) { norm_mod_phase(F, F.out, F.in[18], mod + 6 * DM, mod + 7 * DM, H); } SEAM(10);
  if (IN(11)) { pg8::Gemm g{H, (const bf16_t*)(ws + WS_WGU2), MTOK, 2 * DFF, DM, DM, DM}; pg8::StaticOrder S; S.init(MTOK, 2 * DFF, F.G, cu);
    pg8::EpiSwiglu E{ACT}; pg8::gemm_phase(F.lds, g, S, E, F.wave); } SEAM(11);
  if (IN(12)) { pg8::Gemm g{ACT, (const bf16_t*)(ws + WS_WD2), MTOK, DM, DFF, DFF, DFF}; pg8::StaticOrder S; S.init(MTOK, DM, F.G, cu);
    pg8::EpiResid E{F.out, F.out, mod + 8 * DM, 0.5f}; pg8::gemm_phase(F.lds, g, S, E, F.wave); } SEAM(12);
  if (IN(13)) { final_norm_phase(F, F.out, F.in[22]); }
#undef IN
#undef SEAM
}

extern "C" void kernel_launch(void* const* d_in, const int* in_sizes, int n_in, void* d_out, int out_size, void* d_ws, size_t ws_size, hipStream_t stream) {
  static int grid = 0;
  if (grid == 0) {
    if (n_in != 23 || in_sizes[0] != MTOK * DM || out_size != MTOK * DM || ws_size < WS_END) {
      fprintf(stderr, "kernel_launch: unexpected shapes n_in %d in0 %d out %d ws %zu (need >= %zu)\n", n_in, n_in > 0 ? in_sizes[0] : -1, out_size, ws_size, (size_t)WS_END); grid = -1; return; }
    int dev = 0, cus = 0;
    if (hipGetDevice(&dev) != hipSuccess || hipDeviceGetAttribute(&cus, hipDeviceAttributeMultiprocessorCount, dev) != hipSuccess) { grid = -1; return; }
    if (hipFuncSetAttribute((const void*)mk_fwd, hipFuncAttributeMaxDynamicSharedMemorySize, LDS_BYTES) != hipSuccess) { fprintf(stderr, "kernel_launch: hipFuncSetAttribute failed\n"); grid = -1; return; }
    grid = cus;
  }
  if (grid < 0) return;
  (void)hipMemsetAsync((char*)d_ws + WS_CTL, 0, CTL_ZERO_BYTES, stream);
  Args a{};
  for (int i = 0; i < 23; ++i) a.in[i] = (const float*)d_in[i];
  a.out = (float*)d_out; a.ws = (unsigned char*)d_ws;
#if MK_SINGLE
  a.ph_lo = 0; a.ph_hi = NPHASE;
  hipLaunchKernelGGL(mk_fwd, dim3(grid), dim3(NWAVES * 64), LDS_BYTES, stream, a);
#else
  for (int p = 0; p < NPHASE; ++p) { a.ph_lo = p; a.ph_hi = p + 1; hipLaunchKernelGGL(mk_fwd, dim3(grid), dim3(NWAVES * 64), LDS_BYTES, stream, a); }
#endif
}
```
